# Optimizing an MI355X kernel written in HIP

```python
import jax, jax.numpy as jnp
from jax import lax
import numpy as np

D_MODEL = 1024
BATCH = 2
SEQ = 8192
DEPTH = 2

PLE_DIM = 256
N_MIXERS = 2
N_FOX_LAYERS = (DEPTH + 1) // 2
N_DIL_LAYERS = DEPTH // 2

FOX_HEADS = 16
FOX_HEAD_DIM = D_MODEL // FOX_HEADS
FOX_WIDTH = FOX_HEADS * FOX_HEAD_DIM
FOX_IN = 4 * FOX_WIDTH + FOX_HEADS
QUERY_BLOCK = 128
FORGET_BIAS_CENTER = 2.0

DIL_PATTERN = ((128, 1), (512, 4), (2048, 16))
DIL_GROUPS = len(DIL_PATTERN)
DIL_HEADS_PER_GROUP = 8
DIL_HEAD_DIM = D_MODEL // DIL_HEADS_PER_GROUP
DIL_HEADS = DIL_GROUPS * DIL_HEADS_PER_GROUP
DIL_QKV = DIL_HEADS * DIL_HEAD_DIM
DIL_WIDTH = DIL_HEADS_PER_GROUP * DIL_HEAD_DIM
DIL_IN = 3 * DIL_QKV + DIL_WIDTH
ALIBI_MAX_EXP = 8.0

RMS_EPS = 1e-6

kernel_name = "fox_dilated_hybrid_trunk"


def rms_norm(x, g):
    xf = x.astype(jnp.float32)
    y = xf * lax.rsqrt(jnp.mean(xf * xf, axis=-1, keepdims=True) + RMS_EPS)
    return (y * g.astype(jnp.float32)).astype(x.dtype)


def alibi_slopes(n):
    return 2.0 ** (-ALIBI_MAX_EXP * jnp.arange(1, n + 1, dtype=jnp.float32) / n)


def fox_mixer(h, w_in, b_f, w_out):
    B, S, _ = h.shape
    proj = h @ w_in
    q = proj[..., :FOX_WIDTH].reshape(B, S, FOX_HEADS, FOX_HEAD_DIM)
    k = proj[..., FOX_WIDTH:2 * FOX_WIDTH].reshape(B, S, FOX_HEADS, FOX_HEAD_DIM)
    v = proj[..., 2 * FOX_WIDTH:3 * FOX_WIDTH].reshape(B, S, FOX_HEADS, FOX_HEAD_DIM)
    z = proj[..., 3 * FOX_WIDTH:4 * FOX_WIDTH]
    f_logit = proj[..., 4 * FOX_WIDTH:]
    log_f = jax.nn.log_sigmoid((f_logit + b_f).astype(jnp.float32))
    c = jnp.cumsum(log_f, axis=1)
    nb = S // QUERY_BLOCK
    qb = q.reshape(B, nb, QUERY_BLOCK, FOX_HEADS, FOX_HEAD_DIM).transpose(1, 0, 2, 3, 4)
    cqb = c.reshape(B, nb, QUERY_BLOCK, FOX_HEADS).transpose(1, 0, 3, 2)
    qpos = jnp.arange(S).reshape(nb, QUERY_BLOCK)
    kpos = jnp.arange(S)
    ck = c.transpose(0, 2, 1)
    scale = FOX_HEAD_DIM ** -0.5

    def block(args):
        qi, ci, pi = args
        s = jnp.einsum('bqhd,bkhd->bhqk', qi, k).astype(jnp.float32) * scale
        s = s + ci[..., None] - ck[:, :, None, :]
        s = jnp.where((kpos[None, :] <= pi[:, None])[None, None], s, -jnp.inf)
        pr = jax.nn.softmax(s, axis=-1)
        return jnp.einsum('bhqk,bkhd->bqhd', pr.astype(v.dtype), v)

    o = lax.map(block, (qb, cqb, qpos))
    o = o.transpose(1, 0, 2, 3, 4).reshape(B, S, FOX_WIDTH)
    return (o * jax.nn.silu(z)) @ w_out


def dilated_window_attention(q, k, v, slopes, window, dilation):
    B, S, Hg, hd = q.shape
    L = S // dilation
    nW = window // dilation
    nb = -(-L // nW)
    Lp = nb * nW
    Bd = B * dilation

    def to_blocks(t):
        t = t.reshape(B, L, dilation, Hg, hd).transpose(0, 2, 1, 3, 4).reshape(Bd, L, Hg, hd)
        t = jnp.pad(t, ((0, 0), (0, Lp - L), (0, 0), (0, 0)))
        return t.reshape(Bd, nb, nW, Hg, hd)

    def with_prev(t):
        prev = jnp.pad(t, ((0, 0), (1, 0), (0, 0), (0, 0), (0, 0)))[:, :-1]
        return jnp.concatenate([prev, t], axis=2)

    qb = to_blocks(q)
    kk = with_prev(to_blocks(k))
    vv = with_prev(to_blocks(v))
    i = jnp.arange(nW)[:, None]
    j = jnp.arange(2 * nW)[None, :]
    dist = nW + i - j
    key_pos = (jnp.arange(nb)[:, None, None] - 1) * nW + j[None]
    valid = (dist >= 0)[None] & (dist <= nW)[None] & (key_pos >= 0)
    bias = -slopes.astype(jnp.float32)[:, None, None] * (dist * dilation).astype(jnp.float32)
    scale = hd ** -0.5
    s = jnp.einsum('znqhd,znkhd->znhqk', qb, kk).astype(jnp.float32) * scale + bias[None, None]
    s = jnp.where(valid[None, :, None], s, -jnp.inf)
    lse = jax.nn.logsumexp(s, axis=-1, keepdims=True)
    pr = jnp.exp(s - lse)
    o = jnp.einsum('znhqk,znkhd->znqhd', pr.astype(v.dtype), vv)
    o = o.reshape(Bd, Lp, Hg, hd)[:, :L]
    o = o.reshape(B, dilation, L, Hg, hd).transpose(0, 2, 1, 3, 4).reshape(B, S, Hg, hd)
    lse = lse[..., 0].transpose(0, 1, 3, 2).reshape(Bd, Lp, Hg)[:, :L]
    lse = lse.reshape(B, dilation, L, Hg).transpose(0, 2, 1, 3).reshape(B, S, Hg)
    return o, lse


def dilated_mixer(h, w_in, w_out):
    B, S, _ = h.shape
    proj = h @ w_in
    shp = (B, S, DIL_GROUPS, DIL_HEADS_PER_GROUP, DIL_HEAD_DIM)
    q = proj[..., :DIL_QKV].reshape(shp)
    k = proj[..., DIL_QKV:2 * DIL_QKV].reshape(shp)
    v = proj[..., 2 * DIL_QKV:3 * DIL_QKV].reshape(shp)
    z = proj[..., 3 * DIL_QKV:]
    slopes = alibi_slopes(DIL_HEADS).reshape(DIL_GROUPS, DIL_HEADS_PER_GROUP)
    outs, lses = [], []
    for g, (window, dilation) in enumerate(DIL_PATTERN):
        o, l = dilated_window_attention(q[:, :, g], k[:, :, g], v[:, :, g], slopes[g], window, dilation)
        outs.append(o)
        lses.append(l)
    wts = jax.nn.softmax(jnp.stack(lses), axis=0)
    o = jnp.sum(wts[..., None] * jnp.stack(outs).astype(jnp.float32), axis=0)
    o = o.astype(h.dtype).reshape(B, S, DIL_WIDTH)
    return (o * jax.nn.silu(z)) @ w_out


def setup_inputs(seed: int = 0) -> dict:
    key = jax.random.key(seed)
    ks = jax.random.split(key, 14)
    f32 = jnp.float32
    nrm = lambda k, shape, fan_in: jax.random.normal(k, shape, f32) * fan_in ** -0.5
    return {
        "x": jax.random.normal(ks[0], (BATCH, SEQ, D_MODEL), f32),
        "p": jax.random.normal(ks[1], (DEPTH, BATCH, SEQ, PLE_DIM), f32),
        "fox_norm": 1.0 + 0.02 * jax.random.normal(ks[2], (N_FOX_LAYERS, D_MODEL), f32),
        "fox_w_in": nrm(ks[3], (N_FOX_LAYERS, D_MODEL, FOX_IN), D_MODEL),
        "fox_b_f": FORGET_BIAS_CENTER + 0.5 * jax.random.normal(ks[4], (N_FOX_LAYERS, FOX_HEADS), f32),
        "fox_w_out": nrm(ks[5], (N_FOX_LAYERS, FOX_WIDTH, D_MODEL), FOX_WIDTH),
        "dil_norm": 1.0 + 0.02 * jax.random.normal(ks[6], (N_DIL_LAYERS, D_MODEL), f32),
        "dil_w_in": nrm(ks[7], (N_DIL_LAYERS, D_MODEL, DIL_IN), D_MODEL),
        "dil_w_out": nrm(ks[8], (N_DIL_LAYERS, DIL_WIDTH, D_MODEL), DIL_WIDTH),
        "ple_w_up": nrm(ks[9], (DEPTH, PLE_DIM, D_MODEL), PLE_DIM),
        "ple_w_gate": nrm(ks[10], (DEPTH, D_MODEL, D_MODEL), D_MODEL),
        "final_norm": 1.0 + 0.02 * jax.random.normal(ks[11], (D_MODEL,), f32),
    }


def reference(x, p, fox_norm, fox_w_in, fox_b_f, fox_w_out, dil_norm, dil_w_in, dil_w_out,
              ple_w_up, ple_w_gate, final_norm):
    h = x
    for i in range(DEPTH):
        j = i // N_MIXERS
        if i % N_MIXERS == 0:
            h = h + fox_mixer(rms_norm(h, fox_norm[j]), fox_w_in[j], fox_b_f[j], fox_w_out[j])
        else:
            h = h + dilated_mixer(rms_norm(h, dil_norm[j]), dil_w_in[j], dil_w_out[j])
        h = h + (p[i] @ ple_w_up[i]) * jax.nn.sigmoid(h @ ple_w_gate[i])
    return rms_norm(h, final_norm)
```

```cpp
#include <hip/hip_cooperative_groups.h>
#include <hip/hip_runtime.h>
#include <cstdio>
#include <cstdint>
namespace pg8 {
#define PG8_LAS __attribute__((address_space(3)))
typedef unsigned short bf16_t;
typedef short bf16x8 __attribute__((ext_vector_type(8)));
typedef float f32x4 __attribute__((ext_vector_type(4)));
typedef unsigned u32x4 __attribute__((ext_vector_type(4)));
constexpr int BM = 256, BK = 64, HALF = 128, HTB = HALF * BK * 2  , STAGE_BYTES = 8 * HTB, NXCD = 8, WGM = 8;

__host__ __device__ __forceinline__ int lds_byte(int r, int c) { const int st = (r >> 4) * 2 + (c >> 5), rr = r & 15, cc = c & 31, ob = rr * 64 + cc * 2; return st * 1024 + (ob ^ (((ob >> 9) & 1) << 5)); }
__host__ __device__ __forceinline__ void stage_rc(int b, int& R, int& C) { const int st = b / 1024, sb = b % 1024, swz = sb ^ (((sb >> 9) & 1) << 5); R = (st >> 1) * 16 + swz / 64; C = (st & 1) * 32 + (swz % 64) / 2; }
__host__ __device__ __forceinline__ int perm32(int rho) { const int n = rho >> 4, i = rho & 15; return 8 * (i >> 2) + 4 * n + (i & 3); }

struct Unit { int pm, pn; };
struct Gemm { const bf16_t* A; const bf16_t* Bt; int M, N, K; };

struct StaticOrder {
    int nM, nN, nwg, G, c;
    __host__ __device__ void init(int M, int N, int G_, int c_) { nM = M / BM; nN = N / BM; nwg = nM * nN; G = G_; c = c_; }
    __host__ __device__ bool next(int i, Unit& u) const {
        const long L = (long)i * G + c; if (L >= nwg) return false;
        int wgid = (int)L; { const int q = nwg / NXCD, r = nwg % NXCD, xcd = wgid % NXCD, off = wgid / NXCD; wgid = (xcd < r ? xcd * (q + 1) : r * (q + 1) + (xcd - r) * q) + off; }
        const int nig = WGM * nN, gid = wgid / nig, fm = gid * WGM, gsz = (nM - fm) < WGM ? (nM - fm) : WGM;
        u.pm = fm + ((wgid % nig) % gsz); u.pn = (wgid % nig) / gsz; return true;
    }
    __device__ __forceinline__ void a_ready(const Unit&) const {}
    __device__ __forceinline__ void done(const Unit&) const {}
};

__device__ __forceinline__ unsigned cvt_pk_bf16(float lo, float hi) { unsigned r; asm volatile("v_cvt_pk_bf16_f32 %0, %1, %2" : "=v"(r) : "v"(lo), "v"(hi)); return r; }
typedef float f32x2 __attribute__((ext_vector_type(2)));
__device__ __forceinline__ f32x2 gelu_pk(f32x2 v) {
    const f32x2 av = __builtin_elementwise_abs(v), d = av * 0.2316418882f + 1.0f;
    f32x2 t; t.x = __builtin_amdgcn_rcpf(d.x); t.y = __builtin_amdgcn_rcpf(d.y);
    f32x2 q = t * 0.5307027145f + (-0.7265760135f); q = q * t + 0.7107068705f; q = q * t + (-0.142248368f); q = q * t + 0.127414796f; q = q * t;
    const f32x2 s = (v * v) * (-0.72134752044f);
    f32x2 e; e.x = __builtin_amdgcn_exp2f(s.x); e.y = __builtin_amdgcn_exp2f(s.y);
    const f32x2 m = v * (q * e), r = v - m;
    f32x2 o; o.x = v.x < 0.f ? m.x : r.x; o.y = v.y < 0.f ? m.y : r.y; return o;
}

template <int ACT  > struct EpiBf16 {
    static constexpr bool PERM = true, AFTER_DRAIN = false; static_assert(ACT == 0 || ACT == 1, "EpiBf16: ACT is 0 (none) or 1 (gelu_pk)");
    bf16_t* O; int ldc; const float* bias; int split_cols; size_t split_stride; float scale0;
    __device__ __forceinline__ void operator()(const f32x4 (&acc)[2][2][4][2], const Unit& u, int wr, int wc, int fr, int fq) const {
        const int row0 = u.pm * BM + wr * 64 + fr; int colt = u.pn * BM; bf16_t* base = O;
        float sc = 1.f; if (split_cols) { const int t = colt / split_cols; base += (size_t)t * split_stride; colt -= t * split_cols; if (t == 0) sc = scale0; }
        const int col0 = colt + wc * 32 + 8 * fq, bcol0 = u.pn * BM + wc * 32 + 8 * fq;
        f32x4 bv[2][2];
#pragma unroll
        for (int bj = 0; bj < 2; ++bj)
#pragma unroll
            for (int n = 0; n < 2; ++n) bv[bj][n] = bias ? *(const f32x4*)(bias + bcol0 + bj * HALF + 4 * n) : (f32x4){0.f, 0.f, 0.f, 0.f};
#pragma unroll
        for (int ai = 0; ai < 2; ++ai)
#pragma unroll
            for (int m = 0; m < 4; ++m) { bf16_t* rowp = base + (size_t)(row0 + ai * HALF + m * 16) * ldc + col0;
#pragma unroll
                for (int bj = 0; bj < 2; ++bj) { f32x4 v0 = acc[ai][bj][m][0] + bv[bj][0], v1 = acc[ai][bj][m][1] + bv[bj][1];
                    if (ACT == 1) { f32x2 a = gelu_pk((f32x2){v0[0], v0[1]}), b = gelu_pk((f32x2){v0[2], v0[3]}), c = gelu_pk((f32x2){v1[0], v1[1]}), d = gelu_pk((f32x2){v1[2], v1[3]});
                        v0 = (f32x4){a.x, a.y, b.x, b.y}; v1 = (f32x4){c.x, c.y, d.x, d.y}; }
                    v0 = v0 * sc; v1 = v1 * sc; u32x4 w; w.x = cvt_pk_bf16(v0[0], v0[1]); w.y = cvt_pk_bf16(v0[2], v0[3]); w.z = cvt_pk_bf16(v1[0], v1[1]); w.w = cvt_pk_bf16(v1[2], v1[3]);
                    *(u32x4*)(rowp + bj * HALF) = w; } }
    }
};

__device__ __forceinline__ u32x4 pack8(const f32x4& v0, const f32x4& v1) { u32x4 w; w.x = cvt_pk_bf16(v0[0], v0[1]); w.y = cvt_pk_bf16(v0[2], v0[3]); w.z = cvt_pk_bf16(v1[0], v1[1]); w.w = cvt_pk_bf16(v1[2], v1[3]); return w; }
__device__ __forceinline__ float bf_lo(unsigned w) { return __uint_as_float(w << 16); }
__device__ __forceinline__ float bf_hi(unsigned w) { return __uint_as_float(w & 0xffff0000u); }
__device__ __forceinline__ float sigmoid_f(float x) { return __builtin_amdgcn_rcpf(1.0f + __builtin_amdgcn_exp2f(-1.4426950408889634f * x)); }

struct EpiResid {
    static constexpr bool PERM = true, AFTER_DRAIN = false;
    const float* base; float* out; bf16_t* hb;
    __device__ __forceinline__ void operator()(const f32x4 (&acc)[2][2][4][2], const Unit& u, int wr, int wc, int fr, int fq) const {
        const int row0 = u.pm * BM + wr * 64 + fr, col0 = u.pn * BM + wc * 32 + 8 * fq;
#pragma unroll
        for (int ai = 0; ai < 2; ++ai)
#pragma unroll
            for (int m = 0; m < 4; ++m) { const size_t off = (size_t)(row0 + ai * HALF + m * 16) * 1024 + col0;
#pragma unroll
                for (int bj = 0; bj < 2; ++bj) { const f32x4 b0 = *(const f32x4*)(base + off + bj * HALF), b1 = *(const f32x4*)(base + off + bj * HALF + 4);
                    const f32x4 v0 = acc[ai][bj][m][0] + b0, v1 = acc[ai][bj][m][1] + b1;
                    *(f32x4*)(out + off + bj * HALF) = v0; *(f32x4*)(out + off + bj * HALF + 4) = v1;
                    *(u32x4*)(hb + off + bj * HALF) = pack8(v0, v1); }
                asm volatile("" ::: "memory"); }
    }
};
struct EpiGate {
    static constexpr bool PERM = true, AFTER_DRAIN = false;
    float* h; const bf16_t* U; bf16_t* a1; const float* g; float* ss;
    __device__ __forceinline__ void operator()(const f32x4 (&acc)[2][2][4][2], const Unit& u, int wr, int wc, int fr, int fq) const {
        const int row0 = u.pm * BM + wr * 64 + fr, col0 = u.pn * BM + wc * 32 + 8 * fq;
        f32x4 gv[2][2];
#pragma unroll
        for (int bj = 0; bj < 2; ++bj)
#pragma unroll
            for (int n = 0; n < 2; ++n) gv[bj][n] = a1 ? *(const f32x4*)(g + col0 + bj * HALF + 4 * n) : (f32x4){0.f, 0.f, 0.f, 0.f};
#pragma unroll
        for (int ai = 0; ai < 2; ++ai)
#pragma unroll
            for (int m = 0; m < 4; ++m) { const int row = row0 + ai * HALF + m * 16; const size_t off = (size_t)row * 1024 + col0; float sq = 0.f;
#pragma unroll
                for (int bj = 0; bj < 2; ++bj) { const f32x4 h0 = *(const f32x4*)(h + off + bj * HALF), h1 = *(const f32x4*)(h + off + bj * HALF + 4);
                    const u32x4 uu = *(const u32x4*)(U + off + bj * HALF);
                    const f32x4 a0 = acc[ai][bj][m][0], a1v = acc[ai][bj][m][1];
                    f32x4 v0, v1;
                    v0[0] = h0[0] + bf_lo(uu.x) * sigmoid_f(a0[0]); v0[1] = h0[1] + bf_hi(uu.x) * sigmoid_f(a0[1]);
                    v0[2] = h0[2] + bf_lo(uu.y) * sigmoid_f(a0[2]); v0[3] = h0[3] + bf_hi(uu.y) * sigmoid_f(a0[3]);
                    v1[0] = h1[0] + bf_lo(uu.z) * sigmoid_f(a1v[0]); v1[1] = h1[1] + bf_hi(uu.z) * sigmoid_f(a1v[1]);
                    v1[2] = h1[2] + bf_lo(uu.w) * sigmoid_f(a1v[2]); v1[3] = h1[3] + bf_hi(uu.w) * sigmoid_f(a1v[3]);
                    *(f32x4*)(h + off + bj * HALF) = v0; *(f32x4*)(h + off + bj * HALF + 4) = v1;
                    if (a1) { *(u32x4*)(a1 + off + bj * HALF) = pack8(v0 * gv[bj][0], v1 * gv[bj][1]);
                        sq += (v0[0] * v0[0] + v0[1] * v0[1]) + (v0[2] * v0[2] + v0[3] * v0[3]) + (v1[0] * v1[0] + v1[1] * v1[1]) + (v1[2] * v1[2] + v1[3] * v1[3]); } }
                if (a1) { sq += __shfl_xor(sq, 16); sq += __shfl_xor(sq, 32); if (fq == 0) ss[(size_t)row * 16 + u.pn * 4 + wc] = sq; }
                asm volatile("" ::: "memory"); }
    }
};
struct EpiIn1 {
    static constexpr bool PERM = true, AFTER_DRAIN = false;
    bf16_t* q; bf16_t* k; bf16_t* v; bf16_t* z; const float* ss; float c2d, eps;
    __device__ __forceinline__ void operator()(const f32x4 (&acc)[2][2][4][2], const Unit& u, int wr, int wc, int fr, int fq) const {
        const int row0 = u.pm * BM + wr * 64 + fr; const int t = u.pn / 12;
        bf16_t* base = t == 0 ? q : t == 1 ? k : t == 2 ? v : z; const int ldc = t < 3 ? 3072 : 1024; const float sc = t == 0 ? c2d : 1.f;
        const int col0 = (u.pn - 12 * t) * BM + wc * 32 + 8 * fq;
#pragma unroll
        for (int ai = 0; ai < 2; ++ai)
#pragma unroll
            for (int m = 0; m < 4; ++m) { const int row = row0 + ai * HALF + m * 16;
                const f32x4* sp = (const f32x4*)(ss + (size_t)row * 16); const f32x4 s0 = sp[0], s1 = sp[1], s2 = sp[2], s3 = sp[3];
                const float tot = ((s0[0] + s0[1]) + (s0[2] + s0[3])) + ((s1[0] + s1[1]) + (s1[2] + s1[3])) + ((s2[0] + s2[1]) + (s2[2] + s2[3])) + ((s3[0] + s3[1]) + (s3[2] + s3[3]));
                const float rs = __builtin_amdgcn_rsqf(tot * (1.0f / 1024.0f) + eps) * sc;
                bf16_t* rowp = base + (size_t)row * ldc + col0;
#pragma unroll
                for (int bj = 0; bj < 2; ++bj) *(u32x4*)(rowp + bj * HALF) = pack8(acc[ai][bj][m][0] * rs, acc[ai][bj][m][1] * rs);
                asm volatile("" ::: "memory"); }
    }
};

template <class Epi, class Sched, bool ALIGN_EPI = false, bool SP2 = false>
__device__ __forceinline__ void gemm_phase(PG8_LAS unsigned char* lds, const Gemm g, const Sched& S, const Epi& E) {
    int tid_ = threadIdx.x; asm volatile("" : "+v"(tid_));
    const int tid = tid_, wid = __builtin_amdgcn_readfirstlane(tid >> 6), lane = tid & 63, wr = wid >> 2, wc = wid & 3, fr = lane & 15, fq = lane >> 4;
    const int K = g.K, nt = K / BK;
    unsigned voffA[2], voffB[2];
#pragma unroll
    for (int i = 0; i < 2; ++i) { int R, C; stage_rc(tid * 16 + i * 8192, R, C); const int Rb = Epi::PERM ? ((R & ~31) + perm32(R & 31)) : R;
        voffA[i] = (unsigned)(R * K + C) * 2u; voffB[i] = (unsigned)(Rb * K + C) * 2u; }
    const size_t kstep = (size_t)(BK * 2);
    const size_t hstep = (size_t)HALF * K * 2;
    const size_t tstep = 2 * hstep;
    const unsigned ldsw = (unsigned)wid * 1024u;
    const int aoff = lds_byte(wr * 64 + fr, fq * 8), boff = lds_byte(wc * 32 + fr, fq * 8);
#define PG8_SA(b, h) (((b) * 2 + (h)) * HTB)
#define PG8_SB(b, h) ((4 + (b) * 2 + (h)) * HTB)
#define PG8_STAGE(bufoff, gbase, voff) do { _Pragma("unroll") for (int _i = 0; _i < 2; ++_i) \
        __builtin_amdgcn_global_load_lds((const unsigned*)((const char*)(gbase) + (voff)[_i]), (PG8_LAS unsigned*)(lds + (bufoff) + ldsw + _i * 8192), 16, 0, 0); } while (0)
#define PG8_LDA(dst, b, h) do { _Pragma("unroll") for (int m = 0; m < 4; ++m) _Pragma("unroll") for (int k = 0; k < 2; ++k) dst[m][k] = *(const PG8_LAS bf16x8*)(lds + PG8_SA(b, h) + aoff + m * 2048 + k * 1024); } while (0)
#define PG8_LDB(dst, b, h) do { _Pragma("unroll") for (int n = 0; n < 2; ++n) _Pragma("unroll") for (int k = 0; k < 2; ++k) dst[n][k] = *(const PG8_LAS bf16x8*)(lds + PG8_SB(b, h) + boff + n * 2048 + k * 1024); } while (0)
#define PG8_MMA(ai, bj, At, Bt) do { __builtin_amdgcn_s_setprio(1); _Pragma("unroll") for (int m = 0; m < 4; ++m) _Pragma("unroll") for (int n = 0; n < 2; ++n) _Pragma("unroll") for (int k = 0; k < 2; ++k) \
        acc[ai][bj][m][n] = __builtin_amdgcn_mfma_f32_16x16x32_bf16(Bt[n][k], At[m][k], acc[ai][bj][m][n], 0, 0, 0); __builtin_amdgcn_s_setprio(0); } while (0)
#define PG8_WAIT_V(n) asm volatile("s_waitcnt vmcnt(" #n ")" ::: "memory")
#define PG8_WAIT_L(n) asm volatile("s_waitcnt lgkmcnt(" #n ")" ::: "memory")
#define PG8_BAR __builtin_amdgcn_s_barrier()
#define PG8_SCHED __builtin_amdgcn_sched_barrier(0)
    Unit cur, nxt; int ui = 0;
    if (!S.next(0, cur)) return;
    f32x4 acc[2][2][4][2];
#pragma unroll
    for (int a = 0; a < 2; ++a)
#pragma unroll
        for (int b = 0; b < 2; ++b)
#pragma unroll
            for (int m = 0; m < 4; ++m)
#pragma unroll
                for (int n = 0; n < 2; ++n) acc[a][b][m][n] = (f32x4){0.f, 0.f, 0.f, 0.f};
    bf16x8 At[4][2], B0[2][2], B1[2][2];
    const char* cA = (const char*)g.A + (size_t)cur.pm * tstep; const char* cB = (const char*)g.Bt + (size_t)cur.pn * tstep;
    S.a_ready(cur);
    if constexpr (SP2) {
        PG8_STAGE(PG8_SB(0, 0), cB, voffB); PG8_STAGE(PG8_SB(0, 1), cB + hstep, voffB); PG8_STAGE(PG8_SA(0, 0), cA, voffA); PG8_STAGE(PG8_SA(0, 1), cA + hstep, voffA);
        if (wr == 1) PG8_BAR;
        PG8_WAIT_V(2); PG8_BAR;
        PG8_STAGE(PG8_SB(1, 0), cB + kstep, voffB); PG8_STAGE(PG8_SA(1, 0), cA + kstep, voffA); PG8_STAGE(PG8_SB(1, 1), cB + hstep + kstep, voffB);
        PG8_WAIT_V(6); PG8_BAR;
    } else {
        PG8_STAGE(PG8_SB(0, 0), cB, voffB); PG8_STAGE(PG8_SA(0, 0), cA, voffA); PG8_STAGE(PG8_SB(0, 1), cB + hstep, voffB); PG8_STAGE(PG8_SA(0, 1), cA + hstep, voffA);
        if (wr == 1) PG8_BAR;
        PG8_WAIT_V(4); PG8_BAR;
        PG8_STAGE(PG8_SB(1, 0), cB + kstep, voffB); PG8_STAGE(PG8_SA(1, 0), cA + kstep, voffA); PG8_STAGE(PG8_SB(1, 1), cB + hstep + kstep, voffB);
        PG8_WAIT_V(6); PG8_BAR;
    }
    for (;;) {
        const bool has_next = S.next(ui + 1, nxt);
        const char* nA = has_next ? (const char*)g.A + (size_t)nxt.pm * tstep : cA; const char* nB = has_next ? (const char*)g.Bt + (size_t)nxt.pn * tstep : cB;
        for (int t = 0; t < nt; t += 2) {
            const bool last = (t == nt - 2);
            const char* a1 = cA + (size_t)(t + 1) * kstep;
            const char* a2 = last ? nA : cA + (size_t)(t + 2) * kstep; const char* b2 = last ? nB : cB + (size_t)(t + 2) * kstep;
            const char* a3 = a2 + kstep; const char* b3 = b2 + kstep;
            if (last && has_next) S.a_ready(nxt);
            if constexpr (SP2) {
            PG8_LDB(B0, 0, 0); PG8_LDB(B1, 0, 1); PG8_SCHED; PG8_LDA(At, 0, 0); PG8_STAGE(PG8_SA(1, 1), a1 + hstep, voffA);
            PG8_WAIT_V(8); PG8_WAIT_L(0); PG8_BAR; PG8_MMA(0, 0, At, B0); PG8_MMA(0, 1, At, B1); PG8_BAR; PG8_SCHED;
            PG8_LDA(At, 0, 1); PG8_STAGE(PG8_SB(0, 0), b2, voffB); PG8_STAGE(PG8_SB(0, 1), b2 + hstep, voffB); PG8_STAGE(PG8_SA(0, 0), a2, voffA);
            PG8_WAIT_V(8); PG8_WAIT_L(0); PG8_BAR; PG8_MMA(1, 0, At, B0); PG8_MMA(1, 1, At, B1); PG8_BAR; PG8_SCHED;
            PG8_LDB(B0, 1, 0); PG8_LDB(B1, 1, 1); PG8_SCHED; PG8_LDA(At, 1, 0); PG8_STAGE(PG8_SA(0, 1), a2 + hstep, voffA);
            PG8_WAIT_V(8); PG8_WAIT_L(0); PG8_BAR; PG8_MMA(0, 0, At, B0); PG8_MMA(0, 1, At, B1); PG8_BAR; PG8_SCHED;
            PG8_LDA(At, 1, 1); PG8_STAGE(PG8_SB(1, 0), b3, voffB); PG8_STAGE(PG8_SB(1, 1), b3 + hstep, voffB); PG8_STAGE(PG8_SA(1, 0), a3, voffA);
            PG8_WAIT_V(8); PG8_WAIT_L(0); PG8_BAR; PG8_MMA(1, 0, At, B0); PG8_MMA(1, 1, At, B1); PG8_BAR; PG8_SCHED;
            } else {
            PG8_LDB(B0, 0, 0); PG8_SCHED; PG8_LDA(At, 0, 0); PG8_STAGE(PG8_SA(1, 1), a1 + hstep, voffA);
            PG8_WAIT_L(8); PG8_BAR; PG8_WAIT_L(0); PG8_MMA(0, 0, At, B0); PG8_BAR; PG8_SCHED;
            PG8_LDB(B1, 0, 1); PG8_STAGE(PG8_SB(0, 0), b2, voffB);
            PG8_BAR; PG8_WAIT_L(0); PG8_MMA(0, 1, At, B1); PG8_BAR;
            PG8_LDA(At, 0, 1); PG8_STAGE(PG8_SA(0, 0), a2, voffA);
            PG8_BAR; PG8_WAIT_L(0); PG8_MMA(1, 0, At, B0); PG8_BAR; PG8_SCHED;
            PG8_STAGE(PG8_SB(0, 1), b2 + hstep, voffB);
            PG8_WAIT_V(6); PG8_BAR; PG8_MMA(1, 1, At, B1); PG8_BAR;
            PG8_LDB(B0, 1, 0); PG8_SCHED; PG8_LDA(At, 1, 0); PG8_STAGE(PG8_SA(0, 1), a2 + hstep, voffA);
            PG8_WAIT_L(8); PG8_BAR; PG8_WAIT_L(0); PG8_MMA(0, 0, At, B0); PG8_BAR; PG8_SCHED;
            PG8_LDB(B1, 1, 1); PG8_STAGE(PG8_SB(1, 0), b3, voffB);
            PG8_BAR; PG8_WAIT_L(0); PG8_MMA(0, 1, At, B1); PG8_BAR;
            PG8_LDA(At, 1, 1); PG8_STAGE(PG8_SA(1, 0), a3, voffA);
            PG8_BAR; PG8_WAIT_L(0); PG8_MMA(1, 0, At, B0); PG8_BAR; PG8_SCHED;
            PG8_STAGE(PG8_SB(1, 1), b3 + hstep, voffB);
            PG8_WAIT_V(6); PG8_BAR; PG8_MMA(1, 1, At, B1); PG8_BAR;
            }
        }
        if constexpr (ALIGN_EPI) { if (wr == 0) PG8_BAR; }
        if constexpr (!Epi::AFTER_DRAIN) { E(acc, cur, wr, wc, fr, fq); S.done(cur); }
        if (!has_next) break;
#pragma unroll
        for (int a = 0; a < 2; ++a)
#pragma unroll
            for (int b = 0; b < 2; ++b)
#pragma unroll
                for (int m = 0; m < 4; ++m)
#pragma unroll
                    for (int n = 0; n < 2; ++n) acc[a][b][m][n] = (f32x4){0.f, 0.f, 0.f, 0.f};
        cur = nxt; cA = nA; cB = nB; ++ui;
        if constexpr (ALIGN_EPI) { if (wr == 1) PG8_BAR; }
    }
    PG8_WAIT_V(0);
    if constexpr (!ALIGN_EPI) { if (wr == 0) PG8_BAR; }
    PG8_BAR;
    if constexpr (Epi::AFTER_DRAIN) { E.fused(acc, cur, wr, wc, fr, fq, lds, wid, lane); S.done(cur); }
#undef PG8_SA
#undef PG8_SB
#undef PG8_STAGE
#undef PG8_LDA
#undef PG8_LDB
#undef PG8_MMA
#undef PG8_WAIT_V
#undef PG8_WAIT_L
#undef PG8_BAR
#undef PG8_SCHED
}
}
#include <hip/hip_bf16.h>
#include <cmath>
namespace attn_body {
using bf16=__hip_bfloat16;
using bf16x8=__attribute__((ext_vector_type(8)))short;
using s16x4=__attribute__((ext_vector_type(4)))short;
using f32x16=__attribute__((ext_vector_type(16)))float;
using u32x4=__attribute__((ext_vector_type(4)))unsigned;
constexpr int BATCH=2,NHEAD=16,SEQ=8192,D=64,DM=NHEAD*D;
constexpr int NW=8,QBLK=32,QB=QBLK*NW,KVBLK=64,NQB=SEQ/QB;
constexpr int ATTN_PITCH=DM, ATTN_UNIT_ROWS=QB;
__device__ __forceinline__ int crow(int r,int hi){return (r&3)+8*(r>>2)+4*hi;}
#define SBAR() __builtin_amdgcn_sched_barrier(0)
__device__ __forceinline__ void cmask(f32x16&p0,f32x16&p1,int jb,int qrel,int hi){
  const float NEG=-INFINITY; int kb=64*jb+4*hi;
  #pragma unroll
  for(int r=0;r<16;++r){int kv=kb+(r&3)+8*(r>>2); if(kv>qrel)p0[r]=NEG; if(kv+32>qrel)p1[r]=NEG;}
}

typedef float f32x4_t __attribute__((ext_vector_type(4)));
constexpr int NSLOT=3, SLOTB=8192;
constexpr int LDS_K=0, LDS_V=NSLOT*SLOTB, LDS_WS=2*NSLOT*SLOTB, LDS_OST=LDS_WS+NW*64*4, LDS_CT=LDS_OST+NW*4096, LDS_BYTES=LDS_CT+SEQ*4;
constexpr float C2=0.125f*1.4426950408889634f;
__device__ __forceinline__ void glds16(const void*gsrc,unsigned lds_dst){unsigned keep;
  asm volatile("s_mov_b32 %0, m0\n\ts_mov_b32 m0, %2\n\ts_nop 0\n\tglobal_load_lds_dwordx4 %1, off\n\ts_mov_b32 m0, %0":"=&s"(keep):"v"(gsrc),"s"(lds_dst):"memory");}
__device__ __forceinline__ float max3f(float a,float b,float c){float r;asm("v_max3_f32 %0, %1, %2, %3":"=v"(r):"v"(a),"v"(b),"v"(c));return r;}
__device__ __forceinline__ float max2f(float a,float b){float r;asm("v_max_f32_e32 %0, %1, %2":"=v"(r):"v"(a),"v"(b));return r;}
__device__ __forceinline__ float fadd_s(float a,float b){float r;asm("v_add_f32_e32 %0, %1, %2":"=v"(r):"v"(a),"v"(b));return r;}
__device__ __forceinline__ float fsub_s(float a,float b){float r;asm("v_sub_f32_e32 %0, %1, %2":"=v"(r):"v"(a),"v"(b));return r;}
typedef float f32x2_t __attribute__((ext_vector_type(2))); typedef __bf16 bf16x2_t __attribute__((ext_vector_type(2)));
__device__ __forceinline__ unsigned cvtpk_s(float lo,float hi){f32x2_t v={lo,hi};bf16x2_t b=__builtin_convertvector(v,bf16x2_t);return __builtin_bit_cast(unsigned,b);}
__device__ __forceinline__ float silu_f(float z){return z*__builtin_amdgcn_rcpf(1.0f+__builtin_amdgcn_exp2f(-1.4426950408889634f*z));}
__device__ __forceinline__ unsigned gate2(unsigned o,unsigned z){ const float o0=__uint_as_float(o<<16),o1=__uint_as_float(o&0xffff0000u),z0=__uint_as_float(z<<16),z1=__uint_as_float(z&0xffff0000u); return cvtpk_s(o0*silu_f(z0),o1*silu_f(z1)); }
#define WAIT_BAR(N) asm volatile("s_waitcnt vmcnt(" #N ") lgkmcnt(0)\n\ts_barrier":::"memory")

__device__ __forceinline__ void qkt(f32x16&p0,f32x16&p1,const char*Kslot,const bf16x8*qr,const f32x16&negm,int r32,int hi){
  const char*kb=Kslot+hi*1024+r32*16;
  #pragma unroll
  for(int d0=0;d0<4;++d0){
    const bf16x8 b0=*reinterpret_cast<const bf16x8*>(kb+d0*2048);
    const bf16x8 b1=*reinterpret_cast<const bf16x8*>(kb+d0*2048+512);
    if(d0==0){p0=__builtin_amdgcn_mfma_f32_32x32x16_bf16(b0,qr[0],negm,0,0,0);p1=__builtin_amdgcn_mfma_f32_32x32x16_bf16(b1,qr[0],negm,0,0,0);}
    else{p0=__builtin_amdgcn_mfma_f32_32x32x16_bf16(b0,qr[d0],p0,0,0,0);p1=__builtin_amdgcn_mfma_f32_32x32x16_bf16(b1,qr[d0],p1,0,0,0);}}
}
typedef __attribute__((address_space(3))) const char* lds_cptr;
typedef short v4i16_t __attribute__((ext_vector_type(4)));
__device__ __forceinline__ void kload8(bf16x8*kf,lds_cptr kp){
  kf[0]=*(const __attribute__((address_space(3))) bf16x8*)(kp);      kf[1]=*(const __attribute__((address_space(3))) bf16x8*)(kp+512);
  kf[2]=*(const __attribute__((address_space(3))) bf16x8*)(kp+2048); kf[3]=*(const __attribute__((address_space(3))) bf16x8*)(kp+2560);
  kf[4]=*(const __attribute__((address_space(3))) bf16x8*)(kp+4096); kf[5]=*(const __attribute__((address_space(3))) bf16x8*)(kp+4608);
  kf[6]=*(const __attribute__((address_space(3))) bf16x8*)(kp+6144); kf[7]=*(const __attribute__((address_space(3))) bf16x8*)(kp+6656);
}
__device__ __forceinline__ void kload2(bf16x8*kf,lds_cptr kp,int j){ kf[2*j]=*(const __attribute__((address_space(3))) bf16x8*)(kp+j*2048); kf[2*j+1]=*(const __attribute__((address_space(3))) bf16x8*)(kp+j*2048+512); }
__device__ __forceinline__ s16x4 vtr(lds_cptr p){ return __builtin_bit_cast(s16x4,__builtin_amdgcn_ds_read_tr16_b64_v4i16((__attribute__((address_space(3))) v4i16_t*)p)); }
__device__ __forceinline__ float rowmax(const f32x16&p0,const f32x16&p1){
  float a=max3f(p0[0],p0[1],p1[0]),b=max3f(p0[2],p0[3],p1[1]);a=max3f(a,p1[2],p1[3]);
  #pragma unroll
  for(int r=4;r<16;r+=4){a=max3f(a,p0[r],p0[r+1]);b=max3f(b,p0[r+2],p0[r+3]);a=max3f(a,p1[r],p1[r+1]);b=max3f(b,p1[r+2],p1[r+3]);}
  const float m=max2f(a,b);
  auto rr=__builtin_amdgcn_permlane32_swap(__float_as_uint(m),__float_as_uint(m),false,false);
  return max2f(__uint_as_float(rr[0]),__uint_as_float(rr[1]));
}
__device__ __forceinline__ void pv(f32x16*o,int vb,bf16x8 pa0,bf16x8 pa1,bf16x8 pa2,bf16x8 pa3){
  #pragma unroll
  for(int d0=0;d0<2;++d0){s16x4 lo[4],hi[4];
    #pragma unroll
    for(int ks=0;ks<4;++ks){
      asm volatile("ds_read_b64_tr_b16 %0,%1 offset:%c2":"=&v"(lo[ks]):"v"(vb),"i"(d0*4096+ks*1024):"memory");
      asm volatile("ds_read_b64_tr_b16 %0,%1 offset:%c2":"=&v"(hi[ks]):"v"(vb),"i"(d0*4096+ks*1024+512):"memory");}
    asm volatile("s_waitcnt lgkmcnt(0)":::"memory");SBAR();
    #define PK(k) (bf16x8){lo[k][0],lo[k][1],lo[k][2],lo[k][3],hi[k][0],hi[k][1],hi[k][2],hi[k][3]}
    o[d0]=__builtin_amdgcn_mfma_f32_32x32x16_bf16(pa0,PK(0),o[d0],0,0,0);
    o[d0]=__builtin_amdgcn_mfma_f32_32x32x16_bf16(pa1,PK(1),o[d0],0,0,0);
    o[d0]=__builtin_amdgcn_mfma_f32_32x32x16_bf16(pa2,PK(2),o[d0],0,0,0);
    o[d0]=__builtin_amdgcn_mfma_f32_32x32x16_bf16(pa3,PK(3),o[d0],0,0,0);
    #undef PK
  }
}

#ifndef ATTN_STORE16
#define ATTN_STORE16(p,v) (*(u32x4*)(p)=(v))
#endif
template<int THRL> __device__ __forceinline__ void attn_unit(int b,int h,int qb,const bf16*Q,const bf16*__restrict__ K,const bf16*__restrict__ V,bf16*O,const bf16*__restrict__ Zg,const float*__restrict__ Cg,char*shm){
  int tid_=threadIdx.x; asm volatile("":"+v"(tid_)); const int tid=tid_,lane=tid&63,r32=lane&31,hi=lane>>5; const int wid=__builtin_amdgcn_readfirstlane(tid>>6);
  const long rowbase=(long)b*SEQ; const int q0=qb*QB;
  const bf16*Qw=Q+(rowbase+q0+wid*QBLK)*DM+h*D;
  const bf16*Kh=K+rowbase*DM+h*D,*Vh=V+rowbase*DM+h*D;
  const unsigned lds0=(unsigned)(uintptr_t)shm;
  float*wsf=(float*)(shm+LDS_WS)+wid*64;
  const bf16*ksrc=Kh+(long)lane*DM+wid*8;
  const bf16*vsrc=Vh+(long)(16*(wid&3)+(lane>>2))*DM+(wid>>2)*32+(lane&3)*8;
  const unsigned kdst=lds0+LDS_K+wid*1024, vdst=lds0+LDS_V+wid*1024;
  #define DMA_K(t,slot) glds16(ksrc+(long)(t)*KVBLK*DM,(unsigned)__builtin_amdgcn_readfirstlane(kdst+(slot)))
  #define DMA_V(t,slot) glds16(vsrc+(long)(t)*KVBLK*DM,(unsigned)__builtin_amdgcn_readfirstlane(vdst+(slot)))
  const int vb0=(int)(lds0+LDS_V)+((lane>>4)&1)*32+(lane&3)*8+(4*hi+((lane&15)>>2))*64;
  const char*Kbase=shm+LDS_K; bf16x8 kf[8];
  const lds_cptr shm3=(lds_cptr)shm; const lds_cptr kp0=shm3+LDS_K+hi*1024+r32*16; const lds_cptr vp0=shm3+LDS_V+((lane>>4)&1)*32+(lane&3)*8+(4*hi+((lane&15)>>2))*64;
  const int NT=(q0+QB)/KVBLK;
  DMA_K(0,0);DMA_V(0,0);DMA_K(1,SLOTB);
  bf16x8 qr[4];
  #pragma unroll
  for(int d0=0;d0<4;++d0)qr[d0]=*reinterpret_cast<const bf16x8*>(&Qw[(long)r32*DM+d0*16+hi*8]);
  float mhat=0.f,l_reg=0.f;f32x16 o[2];o[0]=f32x16{};o[1]=f32x16{};f32x16 negm=f32x16{};asm volatile("":"+v"(negm));
  const int qrel=wid*QBLK+r32;
  #define CMASK(P0,P1,t) do{int jb_=(t)-(NT-4); if(jb_>=0)cmask(P0,P1,jb_,qrel,hi);}while(0)
  #define CDEC(P0,P1,t) do{ const lds_f4ptr cb_=(lds_f4ptr)(ctab+64*(t)+4*hi); \
    _Pragma("unroll") for(int g_=0;g_<4;++g_){ const f32x4_t a_=cb_[2*g_], b_=cb_[8+2*g_]; \
      P0[4*g_]-=a_[0];P0[4*g_+1]-=a_[1];P0[4*g_+2]-=a_[2];P0[4*g_+3]-=a_[3]; P1[4*g_]-=b_[0];P1[4*g_+1]-=b_[1];P1[4*g_+2]-=b_[2];P1[4*g_+3]-=b_[3]; } }while(0)
  bool resc=false;
  #define START(P0,P1) do{ const float rm=rowmax(P0,P1); resc=false; \
    { const float dl=rm; mhat=fadd_s(mhat,dl); \
      _Pragma("unroll") for(int r=0;r<16;++r){P0[r]=fsub_s(P0[r],dl);P1[r]=fsub_s(P1[r],dl);} \
      _Pragma("unroll") for(int r=0;r<16;++r)negm[r]=-mhat; asm volatile("":"+v"(negm)); } \
    _Pragma("unroll") for(int r=0;r<16;++r)P0[r]=__builtin_amdgcn_exp2f(P0[r]); }while(0)
  #define RESC() do{ if(resc){ asm volatile("s_waitcnt lgkmcnt(0)":::"memory"); \
      _Pragma("unroll") for(int d_=0;d_<2;++d_) _Pragma("unroll") for(int r=0;r<16;++r)o[d_][r]*=wsf[crow(r,hi)]; } }while(0)
  f32x16 pA0,pA1,pB0,pB1;
  int sl_prev=0,sl_cur=0,sl_next=SLOTB;
  #define ROT() do{sl_prev=sl_cur;sl_cur=sl_next;sl_next=(sl_next==(NSLOT-1)*SLOTB)?0:sl_next+SLOTB;}while(0)
  DMA_K(2,2*SLOTB);
  typedef __attribute__((address_space(3))) float* lds_fptr; typedef __attribute__((address_space(3))) const f32x4_t* lds_f4ptr;
  const lds_fptr ctab=(lds_fptr)(shm3+LDS_CT);
  { const float*cg=Cg+(long)(b*NHEAD+h)*SEQ; const float cref=cg[q0];
    for(int i=tid*4;i<q0+QB;i+=NW*64*4){ f32x4_t v=*(const f32x4_t*)(cg+i); v[0]-=cref;v[1]-=cref;v[2]-=cref;v[3]-=cref; *(__attribute__((address_space(3))) f32x4_t*)(ctab+i)=v; } }
  WAIT_BAR(3);
  mhat=-ctab[q0+wid*QBLK+r32];
  _Pragma("unroll") for(int r=0;r<16;++r)negm[r]=-mhat; asm volatile("":"+v"(negm));
  qkt(pA0,pA1,Kbase,qr,negm,r32,hi);asm volatile("s_nop 15\n\ts_nop 7":"+v"(pA0),"+v"(pA1));CDEC(pA0,pA1,0);CMASK(pA0,pA1,0);
  START(pA0,pA1);
  _Pragma("unroll") for(int r=0;r<16;++r)pA1[r]=__builtin_amdgcn_exp2f(pA1[r]);
  WAIT_BAR(0);
  DMA_K(3,0);DMA_V(1,SLOTB);
  ROT();
  kload8(kf,kp0+sl_cur);
  WAIT_BAR(2);
  s16x4 vlo[8],vhi[8]; u32x4 pw0,pw1,pw2,pw3;
  #define PKW(P,B) cvtpk_s(P[B],P[B+1])
  #define PAF(k) __builtin_bit_cast(bf16x8,pw##k)
  #define VFR(i) (bf16x8){vlo[i][0],vlo[i][1],vlo[i][2],vlo[i][3],vhi[i][0],vhi[i][1],vhi[i][2],vhi[i][3]}
  #define PIN(x) asm volatile("":"+v"(x))
  #define MX3(a,b,c) __builtin_fmaxf(__builtin_fmaxf((a),(b)),(c))
  #define GAPA(MF,A0,A1,A2,A3,W0,W1,PW) do{ MF; sacc+=A0; sacc+=A1; sacc+=A2; sacc+=A3; PIN(sacc); W0; W1; PIN(PW); SBAR(); }while(0)
  #define EX(v) __builtin_amdgcn_exp2f(v)
  #define GAPB(MF,X,B) do{ MF; X[B]=EX(X[B]); X[B+1]=EX(X[B+1]); X[B+2]=EX(X[B+2]); X[B+3]=EX(X[B+3]); PIN(X); SBAR(); }while(0)
  #define VRD(i) do{ vlo[i]=vtr(vp_+(((i)>>2)*4096+((i)&3)*1024)); vhi[i]=vtr(vp_+(((i)>>2)*4096+((i)&3)*1024+512)); }while(0)
  #define KRD(G,j) do{ if(G){ kload2(kf,kp0+sl_next,j); SBAR(); } }while(0)
  #define STEP(C0,C1,P0,P1,t,GK,GV,GL) do{ SBAR(); \
    const lds_cptr vp_=vp0+sl_prev; \
    VRD(0); SBAR(); float sacc=(P0[0]+P0[1]); \
    GAPA(C0=__builtin_amdgcn_mfma_f32_32x32x16_bf16(kf[0],qr[0],negm,0,0,0), P0[2],P0[3],P0[4],P0[5],     pw0[0]=PKW(P0,0), pw0[1]=PKW(P0,2), pw0); \
    VRD(4); SBAR(); GAPA(C1=__builtin_amdgcn_mfma_f32_32x32x16_bf16(kf[1],qr[0],negm,0,0,0), P0[6],P0[7],P0[8],P0[9],     pw0[2]=PKW(P0,4), pw0[3]=PKW(P0,6), pw0); \
    VRD(1); SBAR(); GAPA(C0=__builtin_amdgcn_mfma_f32_32x32x16_bf16(kf[2],qr[1],C0,0,0,0),   P0[10],P0[11],P0[12],P0[13], pw1[0]=PKW(P0,8), pw1[1]=PKW(P0,10), pw1); \
    VRD(5); SBAR(); GAPA(C1=__builtin_amdgcn_mfma_f32_32x32x16_bf16(kf[3],qr[1],C1,0,0,0),   P0[14],P0[15],P1[0],P1[1],   pw1[2]=PKW(P0,12),pw1[3]=PKW(P0,14), pw1); \
    VRD(2); SBAR(); GAPA(C0=__builtin_amdgcn_mfma_f32_32x32x16_bf16(kf[4],qr[2],C0,0,0,0),   P1[2],P1[3],P1[4],P1[5],     pw2[0]=PKW(P1,0), pw2[1]=PKW(P1,2), pw2); \
    VRD(6); SBAR(); GAPA(C1=__builtin_amdgcn_mfma_f32_32x32x16_bf16(kf[5],qr[2],C1,0,0,0),   P1[6],P1[7],P1[8],P1[9],     pw2[2]=PKW(P1,4), pw2[3]=PKW(P1,6), pw2); \
    VRD(3); SBAR(); GAPA(C0=__builtin_amdgcn_mfma_f32_32x32x16_bf16(kf[6],qr[3],C0,0,0,0),   P1[10],P1[11],P1[12],P1[13], pw3[0]=PKW(P1,8), pw3[1]=PKW(P1,10), pw3); \
    VRD(7); SBAR(); GAPA(C1=__builtin_amdgcn_mfma_f32_32x32x16_bf16(kf[7],qr[3],C1,0,0,0),   P1[14],P1[15],0.f,0.f,       pw3[2]=PKW(P1,12),pw3[3]=PKW(P1,14), pw3); \
    l_reg+=sacc; \
    if(GK){DMA_K((t)+3,sl_cur);} if(GV){DMA_V((t)+1,sl_next);} \
    CDEC(C0,C1,t); CMASK(C0,C1,t); \
    { float a=MX3(C0[0],C0[1],C1[0]),b=MX3(C0[2],C0[3],C1[1]); a=MX3(a,C1[2],C1[3]); \
      _Pragma("unroll") for(int r=4;r<16;r+=4){a=MX3(a,C0[r],C0[r+1]);b=MX3(b,C0[r+2],C0[r+3]);a=MX3(a,C1[r],C1[r+1]);b=MX3(b,C1[r+2],C1[r+3]);} \
      float rm=__builtin_fmaxf(a,b); { auto rr=__builtin_amdgcn_permlane32_swap(__float_as_uint(rm),__float_as_uint(rm),false,false); rm=__builtin_fmaxf(__uint_as_float(rr[0]),__uint_as_float(rr[1])); } \
      resc=false; \
      if(__builtin_expect(__any(rm>(float)THRL),0)){ const float dl=__builtin_fmaxf(rm,0.f); mhat+=dl; \
        _Pragma("unroll") for(int r=0;r<16;++r){C0[r]-=dl;C1[r]-=dl;} \
        _Pragma("unroll") for(int r=0;r<16;++r)negm[r]=-mhat; asm volatile("":"+v"(negm)); \
        const float f=__builtin_amdgcn_exp2f(-dl); l_reg*=f; if(hi==0)wsf[r32]=f; resc=true; } } \
    SBAR(); \
    GAPB(o[0]=__builtin_amdgcn_mfma_f32_32x32x16_bf16(PAF(0),VFR(0),o[0],0,0,0), C0,0); \
    GAPB(o[1]=__builtin_amdgcn_mfma_f32_32x32x16_bf16(PAF(0),VFR(4),o[1],0,0,0), C0,4); \
    KRD(GL,0); GAPB(o[0]=__builtin_amdgcn_mfma_f32_32x32x16_bf16(PAF(1),VFR(1),o[0],0,0,0), C0,8); \
    KRD(GL,1); GAPB(o[1]=__builtin_amdgcn_mfma_f32_32x32x16_bf16(PAF(1),VFR(5),o[1],0,0,0), C0,12); \
    KRD(GL,2); GAPB(o[0]=__builtin_amdgcn_mfma_f32_32x32x16_bf16(PAF(2),VFR(2),o[0],0,0,0), C1,0); \
    KRD(GL,3); GAPB(o[1]=__builtin_amdgcn_mfma_f32_32x32x16_bf16(PAF(2),VFR(6),o[1],0,0,0), C1,4); \
    GAPB(o[0]=__builtin_amdgcn_mfma_f32_32x32x16_bf16(PAF(3),VFR(3),o[0],0,0,0), C1,8); \
    GAPB(o[1]=__builtin_amdgcn_mfma_f32_32x32x16_bf16(PAF(3),VFR(7),o[1],0,0,0), C1,12); \
    }while(0)
  int t=1;
  #undef CMASK
  #define CMASK(P0,P1,t) do{}while(0)
  for(;t+5<NT;t+=2){
    STEP(pB0,pB1,pA0,pA1,t,true,true,true);     WAIT_BAR(2); RESC(); ROT();
    STEP(pA0,pA1,pB0,pB1,t+1,true,true,true);   WAIT_BAR(2); RESC(); ROT();
  }
  #undef CMASK
  #define CMASK(P0,P1,t) do{int jb_=(t)-(NT-4); if(jb_>=0)cmask(P0,P1,jb_,qrel,hi);}while(0)
  #define ENDW(tt) do{ if((tt)+3<NT){WAIT_BAR(2);} else if((tt)+2<NT){WAIT_BAR(1);} else {WAIT_BAR(0);} }while(0)
  for(;t+1<NT;t+=2){
    STEP(pB0,pB1,pA0,pA1,t,(t+3<NT),(t+1<NT),(t+1<NT));       ENDW(t);   RESC(); ROT();
    STEP(pA0,pA1,pB0,pB1,t+1,(t+4<NT),(t+2<NT),(t+2<NT));     ENDW(t+1); RESC(); ROT();
  }
  STEP(pB0,pB1,pA0,pA1,NT-1,false,false,false); RESC();
  { float sacc=pB0[0]+pB0[1]; _Pragma("unroll") for(int r=2;r<16;++r)sacc+=pB0[r]; _Pragma("unroll") for(int r=0;r<16;++r)sacc+=pB1[r]; l_reg+=sacc;
    pw0=(u32x4){PKW(pB0,0),PKW(pB0,2),PKW(pB0,4),PKW(pB0,6)};pw1=(u32x4){PKW(pB0,8),PKW(pB0,10),PKW(pB0,12),PKW(pB0,14)};pw2=(u32x4){PKW(pB1,0),PKW(pB1,2),PKW(pB1,4),PKW(pB1,6)};pw3=(u32x4){PKW(pB1,8),PKW(pB1,10),PKW(pB1,12),PKW(pB1,14)};
    SBAR(); pv(o,vb0+sl_cur,PAF(0),PAF(1),PAF(2),PAF(3)); }
  #undef PKW
  #undef PAF
  #undef VFR
  #undef PIN
  #undef MX3
  #undef GAPA
  #undef GAPB
  #undef EX
  #undef VRD
  #undef KRD
  #undef STEP
  #undef ENDW
  {auto rr=__builtin_amdgcn_permlane32_swap(__float_as_uint(l_reg),__float_as_uint(l_reg),false,false);l_reg=__uint_as_float(rr[0])+__uint_as_float(rr[1]);}
  if(hi==0)wsf[32+r32]=l_reg;asm volatile("s_waitcnt lgkmcnt(0)":::"memory");
  float rli[16];
  #pragma unroll
  for(int r=0;r<16;++r)rli[r]=__builtin_amdgcn_rcpf(wsf[32+crow(r,hi)]);
  bf16*Ow=O+(rowbase+q0+wid*QBLK)*DM+h*D;
  { bf16*stg=(bf16*)(shm+LDS_OST)+wid*2048;
    #pragma unroll
    for(int r=0;r<16;++r){const int orow=crow(r,hi);
      #pragma unroll
      for(int d0=0;d0<2;++d0)stg[orow*64+d0*32+r32]=__float2bfloat16(o[d0][r]*rli[r]);}
    asm volatile("s_waitcnt lgkmcnt(0)":::"memory");
    const bf16*Zw=Zg+(rowbase+q0+wid*QBLK)*DM+h*D;
    #pragma unroll
    for(int i=0;i<4;++i){const int row=i*8+(lane>>3),ch=lane&7; const u32x4 v=*(const u32x4*)(stg+row*64+ch*8); const u32x4 zz=*(const u32x4*)(Zw+(long)row*DM+ch*8); u32x4 w;
      w.x=gate2(v.x,zz.x);w.y=gate2(v.y,zz.y);w.z=gate2(v.z,zz.z);w.w=gate2(v.w,zz.w); ATTN_STORE16(Ow+(long)row*DM+ch*8,w);} }
  asm volatile("s_waitcnt lgkmcnt(0)\n\ts_barrier":::"memory");
  #undef DMA_K
  #undef DMA_V
  #undef CMASK
  #undef CDEC
  #undef START
  #undef RESC
  #undef ROT
}
constexpr int ATTN_LDS_BYTES=LDS_BYTES;
struct AttnTensors { const bf16* Q; const bf16* K; const bf16* V; bf16* O; const bf16* Z; const float* C; };
struct AttnUnit { int bh; int qb; };
struct StaticOrder {
  int vcu;
  __device__ __forceinline__ explicit StaticOrder(int grid,int block):vcu((block%8)*(grid/8)+block/8){}
  __device__ __forceinline__ bool next(int i,AttnUnit&u)const{ if(i>=4)return false; const int s=vcu&7; u.bh=vcu>>3; u.qb=(i==0)?s:(i==1)?15-s:(i==2)?16+s:31-s; return true; }
  __device__ __forceinline__ void a_ready(const AttnUnit&)const{}
  __device__ __forceinline__ void done(const AttnUnit&)const{}
};
template<class Sched,int THRL=8> __device__ __forceinline__ void attn_phase(char*lds,const AttnTensors&T,const Sched&S){
  AttnUnit u;
  for(int i=0;S.next(i,u);++i){ S.a_ready(u); attn_unit<THRL>(u.bh/NHEAD,u.bh%NHEAD,u.qb,T.Q,T.K,T.V,T.O,T.Z,T.C,lds); S.done(u); }
}
#undef SBAR
#undef WAIT_BAR
}

#define GAS __attribute__((address_space(1)))
#define LAS __attribute__((address_space(3)))
typedef unsigned short bf16;
typedef unsigned v4u __attribute__((ext_vector_type(4)));
typedef float f32x4 __attribute__((ext_vector_type(4)));
typedef short bf16x8 __attribute__((ext_vector_type(8)));
typedef GAS unsigned gu32;
typedef GAS unsigned long long gu64;
#define RLX_AGENT __ATOMIC_RELAXED, __HIP_MEMORY_SCOPE_AGENT
#define LDS_WAIT() asm volatile("s_waitcnt lgkmcnt(0)" ::: "memory")
#define VM_WAIT() asm volatile("s_waitcnt vmcnt(0)" ::: "memory")
__device__ __forceinline__ unsigned long long rt() { return __builtin_amdgcn_s_memrealtime(); }
__device__ __forceinline__ unsigned f2bf(float f) { unsigned u = __builtin_bit_cast(unsigned, f); return (u + 0x7fffu + ((u >> 16) & 1u)) >> 16; }
__device__ __forceinline__ unsigned pk2(float lo, float hi) { return f2bf(lo) | (f2bf(hi) << 16); }

#define XB_TMO      128
#define XB_XCNT(j)  (256  + 64 * (j))
#define XB_XSUB(j)  (1280 + 64 * (j))
#define XB_XGEN(j)  (2304 + 64 * (j))
#define XB_TOP      3328
#define XB_TOPGEN   3392
#define XCD_BAR_WORDS 3456
#define XB_SPIN_CAP (1u << 18)

__device__ __forceinline__ unsigned xb_ld(unsigned* p)              { return __hip_atomic_load(p, __ATOMIC_RELAXED, __HIP_MEMORY_SCOPE_AGENT); }
__device__ __forceinline__ unsigned xb_add(unsigned* p, unsigned v) { return __hip_atomic_fetch_add(p, v, __ATOMIC_RELAXED, __HIP_MEMORY_SCOPE_AGENT); }
__device__ __forceinline__ unsigned xb_xcc_id() { return (unsigned)__builtin_amdgcn_s_getreg((3 << 11) | 20) & 0xFu; }
#define XB_SPIN(cond, bar) do { unsigned _sp = 0; while (cond) { __builtin_amdgcn_s_sleep(1); \
    if ((++_sp & 255u) == 0u) { if (xb_ld(&(bar)[XB_TMO])) break; if (_sp > XB_SPIN_CAP) { atomicAdd(&(bar)[XB_TMO], 1u); break; } } } } while (0)

struct XcdBarrier {
    unsigned* bar; unsigned x;
    volatile LAS unsigned* st;
};

__device__ __forceinline__ XcdBarrier xcd_barrier_post(unsigned* bar, volatile LAS unsigned* st) {
    XcdBarrier b; b.bar = bar; b.x = xb_xcc_id(); b.st = st;
    if (threadIdx.x == 0) (void)xb_add(&bar[XB_XCNT(b.x)], 1u);
    return b;
}
__device__ __forceinline__ void xcd_barrier_complete(unsigned* bar, unsigned x, unsigned& nloc, unsigned& nx) {
    const unsigned G = gridDim.x * gridDim.y * gridDim.z;
    unsigned sum, cnt, mine, sp = 0u;
    for (;;) {
        sum = 0u; cnt = 0u; mine = 0u;
#pragma unroll
        for (unsigned j = 0; j < 16; ++j) { const unsigned c = xb_ld(&bar[XB_XCNT(j)]); sum += c; cnt += (c > 0u) ? 1u : 0u; mine = (j == x) ? c : mine; }
        if (sum == G) break;
        __builtin_amdgcn_s_sleep(1);
        if ((++sp & 255u) == 0u) { if (xb_ld(&bar[XB_TMO])) break; if (sp > XB_SPIN_CAP) { atomicAdd(&bar[XB_TMO], 1u); break; } }
    }
    nloc = mine > 0u ? mine : 1u; nx = cnt > 0u ? cnt : 1u;
}

__device__ __forceinline__ void xcd_barrier(const XcdBarrier& b) {
    asm volatile("s_waitcnt vmcnt(0)" ::: "memory");
    __syncthreads();
    if (threadIdx.x == 0) {
        unsigned* bar = b.bar;
        __builtin_amdgcn_s_waitcnt(0);
        unsigned nloc = b.st[0], nx = b.st[1];
        if (nloc == 0u) { xcd_barrier_complete(bar, b.x, nloc, nx); b.st[0] = nloc; b.st[1] = nx; }
        const unsigned old = xb_add(&bar[XB_XSUB(b.x)], 1u);
        const unsigned gen = old / nloc;
        if (old + 1u == (gen + 1u) * nloc) {
            __builtin_amdgcn_fence(__ATOMIC_RELEASE, "agent");
            asm volatile("s_waitcnt vmcnt(0)" ::: "memory");
            const unsigned og = xb_add(&bar[XB_TOP], 1u);
            const unsigned tg = og / nx;
            if (og + 1u == (tg + 1u) * nx) xb_add(&bar[XB_TOPGEN], 1u);
            else XB_SPIN(xb_ld(&bar[XB_TOPGEN]) == tg, bar);
            __builtin_amdgcn_fence(__ATOMIC_ACQUIRE, "agent");
            xb_add(&bar[XB_XGEN(b.x)], 1u);
            asm volatile("s_waitcnt vmcnt(0)" ::: "memory");
        } else {
            XB_SPIN(xb_ld(&bar[XB_XGEN(b.x)]) == gen, bar);
            __builtin_amdgcn_fence(__ATOMIC_ACQUIRE, "agent");
            asm volatile("s_waitcnt vmcnt(0)" ::: "memory");
        }
    }
    __syncthreads();
}

namespace dil {
using attn_body::bf16x8; using attn_body::s16x4; using attn_body::f32x16; using attn_body::u32x4; using attn_body::lds_cptr; using attn_body::vtr; using attn_body::cvtpk_s; using attn_body::crow;
constexpr int KS = 272, VS = 320, KBYTES = 64 * KS, VBYTES = 64 * VS, UNIT_LDS = KBYTES + VBYTES;
constexpr int WSF_OFF = 2 * UNIT_LDS, DIL_LDS_BYTES = WSF_OFF + 8 * 256;
constexpr int LDQ = 3072;
typedef __attribute__((address_space(3))) char* lds_ptr;
typedef __attribute__((address_space(3))) float* lds_fp;

__device__ __forceinline__ void dil_phase(char* lds_g, unsigned short* Qb, const unsigned short* __restrict__ Kb, const unsigned short* __restrict__ Vb, float* lse, int grid, int block) {
    int tid_ = threadIdx.x; asm volatile("" : "+v"(tid_)); const int tid = tid_, lane = tid & 63, r32 = lane & 31, hi = lane >> 5; const int wid = __builtin_amdgcn_readfirstlane(tid >> 6);
    const int half = wid >> 2, w4 = wid & 3, tu = tid & 255;
    const lds_ptr lds = (lds_ptr)lds_g;
    const lds_ptr Kl = lds + half * UNIT_LDS, Vl = Kl + KBYTES;
    const lds_fp wsf = (lds_fp)(lds + WSF_OFF) + wid * 64;
    for (int up = block; up < 768; up += grid) {
        const int u = 2 * up + half;
        const int g = u >> 9, rem = u & 511, h = rem & 7, pb = rem >> 3, dsh = 2 * g;
        const int nbm = (64 >> dsh) - 1, n = pb & nbm, r = pb >> (6 - dsh);
        const int colq = g * 1024 + h * 128;
        const int i_q = 32 * w4 + r32;
        const long tq = ((long)(128 * n + i_q) << dsh) + r;
        bf16x8 qr[8];
#pragma unroll
        for (int d0 = 0; d0 < 8; ++d0) qr[d0] = *(const bf16x8*)(Qb + tq * LDQ + colq + d0 * 16 + hi * 8);
        const float slope2 = __builtin_amdgcn_exp2f(-(float)(g * 8 + h + 1) * (8.0f / 24.0f)) * 1.4426950408889634f * (float)(1 << dsh);
        float mrun = -1e30f, l_reg = 0.f; f32x16 o[4];
#pragma unroll
        for (int d0 = 0; d0 < 4; ++d0) o[d0] = f32x16{};
        u32x4 kreg[4], vreg[4];
#define DIL_LOAD(kt) do { _Pragma("unroll") for (int i_ = 0; i_ < 4; ++i_) { const int p_ = tu + 256 * i_, row_ = p_ >> 4, ch_ = p_ & 15; \
            int lk_ = 128 * (n - 1) + 64 * (kt) + row_; lk_ = lk_ < 0 ? 0 : lk_; const long tk_ = ((long)lk_ << dsh) + r; \
            kreg[i_] = *(const u32x4*)(Kb + tk_ * LDQ + colq + ch_ * 8); vreg[i_] = *(const u32x4*)(Vb + tk_ * LDQ + colq + ch_ * 8); } } while (0)
        DIL_LOAD(0);
        const lds_cptr kb = (lds_cptr)Kl + r32 * KS + hi * 16;
        const lds_cptr vb = (lds_cptr)Vl + (4 * hi + ((lane & 15) >> 2)) * VS + ((lane >> 4) & 1) * 32 + (lane & 3) * 8;
#pragma unroll 1
        for (int kt = 0; kt < 4; ++kt) {
            __syncthreads();
#pragma unroll
            for (int i_ = 0; i_ < 4; ++i_) { const int p_ = tu + 256 * i_, row_ = p_ >> 4, ch_ = p_ & 15;
                *(__attribute__((address_space(3))) u32x4*)(Kl + row_ * KS + ch_ * 16) = kreg[i_]; *(__attribute__((address_space(3))) u32x4*)(Vl + row_ * VS + ch_ * 16) = vreg[i_]; }
            __syncthreads();
            if (kt < 3) DIL_LOAD(kt + 1);
            const bool active = (kt >= (w4 >> 1)) && (kt <= (w4 >> 1) + 2) && !(n == 0 && kt < 2);
            if (active) {
                f32x16 p0 = f32x16{}, p1 = f32x16{};
#pragma unroll
                for (int d0 = 0; d0 < 8; ++d0) {
                    const bf16x8 b0 = *(const __attribute__((address_space(3))) bf16x8*)(kb + d0 * 32);
                    const bf16x8 b1 = *(const __attribute__((address_space(3))) bf16x8*)(kb + 32 * KS + d0 * 32);
                    p0 = __builtin_amdgcn_mfma_f32_32x32x16_bf16(b0, qr[d0], p0, 0, 0, 0);
                    p1 = __builtin_amdgcn_mfma_f32_32x32x16_bf16(b1, qr[d0], p1, 0, 0, 0);
                }
                const int dbase = 128 + i_q - 64 * kt - 4 * hi; const bool nz = n > 0; const int jb = 64 * kt + 4 * hi;
                float rm = -INFINITY;
#pragma unroll
                for (int rr = 0; rr < 16; ++rr) { const int cr = (rr & 3) + 8 * (rr >> 2); const int d0_ = dbase - cr, d1_ = d0_ - 32;
                    const bool v0 = ((unsigned)d0_ <= 128u) && (nz || (jb + cr) >= 128), v1 = ((unsigned)d1_ <= 128u) && (nz || (jb + cr + 32) >= 128);
                    p0[rr] = v0 ? p0[rr] - slope2 * (float)d0_ : -INFINITY; p1[rr] = v1 ? p1[rr] - slope2 * (float)d1_ : -INFINITY;
                    rm = fmaxf(rm, fmaxf(p0[rr], p1[rr])); }
                rm = fmaxf(rm, __shfl_xor(rm, 32));
                const float mnew = fmaxf(mrun, rm), alpha = __builtin_amdgcn_exp2f(mrun - mnew); mrun = mnew;
                float rs = 0.f;
#pragma unroll
                for (int rr = 0; rr < 16; ++rr) { p0[rr] = __builtin_amdgcn_exp2f(p0[rr] - mnew); p1[rr] = __builtin_amdgcn_exp2f(p1[rr] - mnew); rs += p0[rr] + p1[rr]; }
                l_reg = l_reg * alpha + rs;
                if (hi == 0) wsf[r32] = alpha;
                bf16x8 pa[4];
                { u32x4 w0, w1, w2, w3;
                  w0.x = cvtpk_s(p0[0], p0[1]); w0.y = cvtpk_s(p0[2], p0[3]); w0.z = cvtpk_s(p0[4], p0[5]); w0.w = cvtpk_s(p0[6], p0[7]);
                  w1.x = cvtpk_s(p0[8], p0[9]); w1.y = cvtpk_s(p0[10], p0[11]); w1.z = cvtpk_s(p0[12], p0[13]); w1.w = cvtpk_s(p0[14], p0[15]);
                  w2.x = cvtpk_s(p1[0], p1[1]); w2.y = cvtpk_s(p1[2], p1[3]); w2.z = cvtpk_s(p1[4], p1[5]); w2.w = cvtpk_s(p1[6], p1[7]);
                  w3.x = cvtpk_s(p1[8], p1[9]); w3.y = cvtpk_s(p1[10], p1[11]); w3.z = cvtpk_s(p1[12], p1[13]); w3.w = cvtpk_s(p1[14], p1[15]);
                  pa[0] = __builtin_bit_cast(bf16x8, w0); pa[1] = __builtin_bit_cast(bf16x8, w1); pa[2] = __builtin_bit_cast(bf16x8, w2); pa[3] = __builtin_bit_cast(bf16x8, w3); }
                { float al[16];
#pragma unroll
                  for (int rr = 0; rr < 16; ++rr) al[rr] = wsf[crow(rr, hi)];
#pragma unroll
                  for (int d0 = 0; d0 < 4; ++d0)
#pragma unroll
                      for (int rr = 0; rr < 16; ++rr) o[d0][rr] *= al[rr]; }
#pragma unroll
                for (int d0 = 0; d0 < 4; ++d0)
#pragma unroll
                    for (int ks = 0; ks < 4; ++ks) {
                        const s16x4 lo = vtr(vb + ks * 16 * VS + d0 * 64), hh = vtr(vb + ks * 16 * VS + 8 * VS + d0 * 64);
                        const bf16x8 vf = (bf16x8){lo[0], lo[1], lo[2], lo[3], hh[0], hh[1], hh[2], hh[3]};
                        o[d0] = __builtin_amdgcn_mfma_f32_32x32x16_bf16(pa[ks], vf, o[d0], 0, 0, 0);
                    }
            }
        }
#undef DIL_LOAD
        const float ltot = l_reg + __shfl_xor(l_reg, 32);
        if (hi == 0) { wsf[32 + r32] = __builtin_amdgcn_rcpf(ltot); lse[((size_t)g * 8192 + tq) * 8 + h] = mrun + log2f(ltot); }
        __syncthreads();
        { const lds_ptr stg = Kl + w4 * 8192;
          float rl[16];
#pragma unroll
          for (int rr = 0; rr < 16; ++rr) rl[rr] = wsf[32 + crow(rr, hi)];
#pragma unroll
          for (int rr = 0; rr < 16; ++rr) { const int orow = crow(rr, hi);
#pragma unroll
              for (int d0 = 0; d0 < 4; ++d0) { const unsigned pk = cvtpk_s(o[d0][rr] * rl[rr], 0.f); *(__attribute__((address_space(3))) unsigned short*)(stg + orow * 256 + (d0 * 32 + r32) * 2) = (unsigned short)pk; } }
#pragma unroll
          for (int i_ = 0; i_ < 8; ++i_) { const int row = i_ * 4 + (lane >> 4), ch = lane & 15;
              const u32x4 v = *(const __attribute__((address_space(3))) u32x4*)(stg + row * 256 + ch * 16);
              const long tr = ((long)(128 * n + 32 * w4 + row) << dsh) + r;
              *(u32x4*)(Qb + tr * LDQ + colq + ch * 8) = v; } }
    }
    __syncthreads();
}
}

namespace cg = cooperative_groups;
constexpr int NWAVES = 8;
constexpr int BATCH = 2, SEQ = 8192, D = 1024, M = BATCH * SEQ, FOX_IN = 4112, DIL_IN = 10240, PLE = 256;
constexpr float RMS_EPS = 1e-6f, LOG2E = 1.4426950408889634f;
constexpr float C2D = 0.08838834764831845f * LOG2E;

constexpr size_t MiB = 1u << 20, KiB = 1024;
constexpr size_t WS_CTL = 0, CTL_ZERO_BYTES = 1 * MiB;
constexpr size_t WS_SS = 1 * MiB;
constexpr size_t WS_C = 2 * MiB;
constexpr size_t WS_LSE = 3 * MiB;
constexpr size_t WS_WFIN = 4 * MiB, WS_WFOUT = 12 * MiB, WS_WUP0 = 14 * MiB, WS_WG0 = 14 * MiB + 512 * KiB, WS_PB0 = 16 * MiB + 512 * KiB;
constexpr size_t WS_A1 = 24 * MiB + 512 * KiB;
constexpr size_t WS_PB1 = 56 * MiB + 512 * KiB, WS_WUP1 = 64 * MiB + 512 * KiB, WS_WG1 = 65 * MiB, WS_WDOUT = 67 * MiB, WS_WDIN = 69 * MiB;
constexpr size_t WS_Q = 89 * MiB, WS_K = 121 * MiB, WS_V = 153 * MiB, WS_Z = 185 * MiB;
constexpr size_t WS_Q1 = 89 * MiB, WS_K1 = 137 * MiB, WS_V1 = 185 * MiB, WS_Z1 = 233 * MiB;
constexpr size_t WS_A2 = 4 * MiB;
constexpr size_t WS_H3B = 89 * MiB, WS_U1 = 121 * MiB;
constexpr size_t WS_END = 256 * MiB;
static_assert(WS_WDIN + (size_t)DIL_IN * D * 2 <= WS_Q && WS_Z1 + (size_t)SEQ * D * 2 <= WS_END && WS_A2 + (size_t)M * D * 2 <= WS_A1 + (size_t)SEQ * D * 2, "d_ws map");
constexpr int CW_BAR = 4096;

constexpr int RING_OFF = 0, RING_BYTES = 131072;
constexpr int LDS_BYTES = 147456, LDSCTL_OFF = LDS_BYTES - 512, MISC_OFF = LDSCTL_OFF + 320;
static_assert(attn_body::LDS_BYTES <= RING_BYTES && dil::DIL_LDS_BYTES <= RING_BYTES, "LDS map");

struct Args { const float* in[12]; float* out; unsigned char* ws; };

__device__ __forceinline__ float wave_sum(float v) {
#pragma unroll
    for (int o = 1; o < 64; o <<= 1) v += __shfl_xor(v, o);
    return v;
}
__device__ __forceinline__ void p0_transpose_item(const float* W, int K, int ldw, int nblk, bf16* WT, LAS float* scr, int item, int lane) {
    const int kb = item / nblk, nb = item % nblk, k0 = 64 * kb, n0 = 32 * nb;
#pragma unroll 8
    for (int i = 0; i < 32; ++i) { const int kk = 2 * i + (lane >> 5); scr[kk * 33 + (lane & 31)] = W[(size_t)(k0 + kk) * ldw + n0 + (lane & 31)]; }
    LDS_WAIT(); asm volatile("" ::: "memory");
    const int c = lane & 7;
#pragma unroll
    for (int j = 0; j < 4; ++j) { const int n = (lane >> 3) + 8 * j; const LAS float* s = scr + (8 * c) * 33 + n;
        v4u o; o.x = pk2(s[0 * 33], s[1 * 33]); o.y = pk2(s[2 * 33], s[3 * 33]); o.z = pk2(s[4 * 33], s[5 * 33]); o.w = pk2(s[6 * 33], s[7 * 33]);
        *(GAS v4u*)(WT + (size_t)(n0 + n) * K + k0 + 8 * c) = o; }
    LDS_WAIT(); asm volatile("" ::: "memory");
}

__global__ void __launch_bounds__(NWAVES * 64, 2) trunk_fwd(Args args) {
    extern __shared__ __attribute__((aligned(16))) unsigned char lds[];
    LAS unsigned char* const ldsl = (LAS unsigned char*)lds;
    volatile LAS unsigned* const MISC = (volatile LAS unsigned*)(ldsl + MISC_OFF);
    const int tid0 = threadIdx.x, wave = __builtin_amdgcn_readfirstlane(tid0 >> 6);
#define FRESH_TID() int tid = tid0; asm volatile("" : "+v"(tid)); const int lane = tid & 63; (void)lane
    const int G = gridDim.x, bx = blockIdx.x, vcu = (G % 8 == 0) ? (bx % 8) * (G / 8) + bx / 8 : bx;
    unsigned char* const ws = args.ws;
    gu32* const ctl = (gu32*)(ws + WS_CTL);
    const float* const x = args.in[0]; const float* const p = args.in[1]; const float* const fox_norm = args.in[2]; const float* const fox_w_in = args.in[3];
    const float* const fox_b_f = args.in[4]; const float* const fox_w_out = args.in[5]; const float* const dil_norm = args.in[6]; const float* const dil_w_in = args.in[7];
    const float* const dil_w_out = args.in[8]; const float* const ple_w_up = args.in[9]; const float* const ple_w_gate = args.in[10]; const float* const final_norm = args.in[11];
    float* const hres = args.out;
    bf16* const W_FIN = (bf16*)(ws + WS_WFIN); bf16* const W_FOUT = (bf16*)(ws + WS_WFOUT); bf16* const W_UP0 = (bf16*)(ws + WS_WUP0); bf16* const W_G0 = (bf16*)(ws + WS_WG0);
    bf16* const W_UP1 = (bf16*)(ws + WS_WUP1); bf16* const W_G1 = (bf16*)(ws + WS_WG1); bf16* const W_DOUT = (bf16*)(ws + WS_WDOUT); bf16* const W_DIN = (bf16*)(ws + WS_WDIN);
    bf16* const PB0 = (bf16*)(ws + WS_PB0); bf16* const PB1 = (bf16*)(ws + WS_PB1); bf16* const A1 = (bf16*)(ws + WS_A1); bf16* const A2 = (bf16*)(ws + WS_A2);
    bf16* const QB = (bf16*)(ws + WS_Q); bf16* const KB = (bf16*)(ws + WS_K); bf16* const VB = (bf16*)(ws + WS_V); bf16* const ZB = (bf16*)(ws + WS_Z);
    bf16* const Q1 = (bf16*)(ws + WS_Q1); bf16* const K1 = (bf16*)(ws + WS_K1); bf16* const V1 = (bf16*)(ws + WS_V1); bf16* const Z1 = (bf16*)(ws + WS_Z1);
    float* const SS = (float*)(ws + WS_SS); float* const CC = (float*)(ws + WS_C); float* const LSE = (float*)(ws + WS_LSE);

    for (int u = tid0; u < (LDS_BYTES - LDSCTL_OFF) / 4; u += NWAVES * 64) ((LAS unsigned*)(ldsl + LDSCTL_OFF))[u] = 0u;
    __syncthreads();
    XcdBarrier bar = xcd_barrier_post((unsigned*)(ctl + CW_BAR), MISC + 8);
    const int gw = vcu * NWAVES + wave, NGW = G * NWAVES;

    {
        FRESH_TID();
        LAS float* scr = (LAS float*)(ldsl + wave * 16384);
        constexpr int I_FIN = 16 * 128, I_SQ = 16 * 32, I_DIN = 16 * 320, I_UP = 4 * 32;
        constexpr int NITEMS = I_FIN + 4 * I_SQ + I_DIN + 2 * I_UP;
        for (int it = gw; it < NITEMS; it += NGW) {
            int r = it;
            if (r < I_DIN) { p0_transpose_item(dil_w_in, D, DIL_IN, 320, W_DIN, scr, r, lane); continue; } r -= I_DIN;
            if (r < I_FIN) { p0_transpose_item(fox_w_in, D, FOX_IN, 128, W_FIN, scr, r, lane); continue; } r -= I_FIN;
            if (r < I_SQ) { p0_transpose_item(fox_w_out, D, D, 32, W_FOUT, scr, r, lane); continue; } r -= I_SQ;
            if (r < I_SQ) { p0_transpose_item(dil_w_out, D, D, 32, W_DOUT, scr, r, lane); continue; } r -= I_SQ;
            if (r < I_SQ) { p0_transpose_item(ple_w_gate, D, D, 32, W_G0, scr, r, lane); continue; } r -= I_SQ;
            if (r < I_SQ) { p0_transpose_item(ple_w_gate + (size_t)D * D, D, D, 32, W_G1, scr, r, lane); continue; } r -= I_SQ;
            if (r < I_UP) { p0_transpose_item(ple_w_up, PLE, D, 32, W_UP0, scr, r, lane); continue; } r -= I_UP;
            p0_transpose_item(ple_w_up + (size_t)PLE * D, PLE, D, 32, W_UP1, scr, r, lane);
        }
        { const size_t n8 = (size_t)2 * M * PLE / 8, half8 = (size_t)M * PLE / 8;
          for (size_t i = (size_t)gw * 64 + lane; i < n8; i += (size_t)NGW * 64) {
              const f32x4 a = *(const GAS f32x4*)(p + i * 8), b = *(const GAS f32x4*)(p + i * 8 + 4);
              v4u o; o.x = pk2(a[0], a[1]); o.y = pk2(a[2], a[3]); o.z = pk2(b[0], b[1]); o.w = pk2(b[2], b[3]);
              bf16* dst = i < half8 ? PB0 + i * 8 : PB1 + (i - half8) * 8; *(GAS v4u*)dst = o; } }
        __syncthreads();
        LAS float* wf = (LAS float*)ldsl;
        for (int idx = tid; idx < 16 * 1024; idx += NWAVES * 64) { const int k = idx >> 4, n = idx & 15; wf[n * 1024 + k] = fox_w_in[(size_t)k * FOX_IN + 4096 + n]; }
        __syncthreads();
        f32x4 g4[4];
#pragma unroll
        for (int j = 0; j < 4; ++j) g4[j] = *(const GAS f32x4*)(fox_norm + 4 * lane + 256 * j);
        for (int m = 2 * gw; m < M; m += 2 * NGW) {
            f32x4 v[2][4]; float s2[2] = {0.f, 0.f};
#pragma unroll
            for (int rr = 0; rr < 2; ++rr)
#pragma unroll
                for (int j = 0; j < 4; ++j) { v[rr][j] = *(const GAS f32x4*)(x + (size_t)(m + rr) * D + 4 * lane + 256 * j); s2[rr] += (v[rr][j].x * v[rr][j].x + v[rr][j].y * v[rr][j].y) + (v[rr][j].z * v[rr][j].z + v[rr][j].w * v[rr][j].w); }
#pragma unroll
            for (int rr = 0; rr < 2; ++rr) { const float rstd = 1.0f / sqrtf(wave_sum(s2[rr]) * (1.f / D) + RMS_EPS);
                GAS unsigned long long* o8 = (GAS unsigned long long*)(A1 + (size_t)(m + rr) * D) + lane;
#pragma unroll
                for (int j = 0; j < 4; ++j) { v[rr][j] = v[rr][j] * rstd * g4[j];
                    o8[64 * j] = (unsigned long long)pk2(v[rr][j].x, v[rr][j].y) | ((unsigned long long)pk2(v[rr][j].z, v[rr][j].w) << 32); } }
            float a0[16], a1[16];
#pragma unroll
            for (int n = 0; n < 16; ++n) { float t0 = 0.f, t1 = 0.f;
#pragma unroll
                for (int j = 0; j < 4; ++j) { const f32x4 w = *(const LAS f32x4*)(wf + n * 1024 + 256 * j + 4 * lane);
                    t0 += (v[0][j].x * w.x + v[0][j].y * w.y) + (v[0][j].z * w.z + v[0][j].w * w.w); t1 += (v[1][j].x * w.x + v[1][j].y * w.y) + (v[1][j].z * w.z + v[1][j].w * w.w); }
                a0[n] = t0; a1[n] = t1; if (n & 1) asm volatile("" ::: "memory"); }
#define TRED(a) do { \
            { const bool up_ = (lane & 32) != 0; _Pragma("unroll") for (int i = 0; i < 8; ++i) { const float snd = up_ ? a[i] : a[i + 8], kp = up_ ? a[i + 8] : a[i]; a[i] = kp + __shfl_xor(snd, 32); } } \
            { const bool up_ = (lane & 16) != 0; _Pragma("unroll") for (int i = 0; i < 4; ++i) { const float snd = up_ ? a[i] : a[i + 4], kp = up_ ? a[i + 4] : a[i]; a[i] = kp + __shfl_xor(snd, 16); } } \
            { const bool up_ = (lane & 8) != 0; _Pragma("unroll") for (int i = 0; i < 2; ++i) { const float snd = up_ ? a[i] : a[i + 2], kp = up_ ? a[i + 2] : a[i]; a[i] = kp + __shfl_xor(snd, 8); } } \
            { const bool up_ = (lane & 4) != 0; const float snd = up_ ? a[0] : a[1], kp = up_ ? a[1] : a[0]; a[0] = kp + __shfl_xor(snd, 4); } \
            a[0] += __shfl_xor(a[0], 1); a[0] += __shfl_xor(a[0], 2); } while (0)
            TRED(a0); TRED(a1);
#undef TRED
            if ((lane & 3) == 0) { const int n = (lane >> 2) & 15; const float bf = fox_b_f[n];
#pragma unroll
                for (int rr = 0; rr < 2; ++rr) { const float fl = (rr ? a1[0] : a0[0]) + bf;
                    const float lf = fminf(fl, 0.f) - log1pf(expf(-fabsf(fl)));
                    const int mm = m + rr, b = mm / SEQ, s = mm % SEQ; CC[(size_t)(b * 16 + n) * SEQ + s] = lf; } }
        }
    }
    cg::this_grid().sync();

    if (bx < 32) {
        FRESH_TID();
        float* c = CC + (size_t)bx * SEQ + tid * 16; LAS float* wt = (LAS float*)(ldsl + LDSCTL_OFF);
        f32x4 v[4]; float run = 0.f;
#pragma unroll
        for (int j = 0; j < 4; ++j) { v[j] = *(const GAS f32x4*)(c + 4 * j); v[j].x += run; v[j].y += v[j].x; v[j].z += v[j].y; v[j].w += v[j].z; run = v[j].w; }
        float inc = run;
#pragma unroll
        for (int o = 1; o < 64; o <<= 1) { const float t = __shfl_up(inc, o); if (lane >= o) inc += t; }
        if (lane == 63) wt[wave] = inc;
        __syncthreads();
        float off = inc - run;
        for (int w = 0; w < wave; ++w) off += wt[w];
#pragma unroll
        for (int j = 0; j < 4; ++j) { v[j] = (v[j] + off) * LOG2E; *(GAS f32x4*)(c + 4 * j) = v[j]; }
        __syncthreads();
    }
    {
        pg8::Gemm g{A1, W_FIN, M, 4096, D}; pg8::StaticOrder S; S.init(M, 4096, G, bx);
        pg8::EpiBf16<0> E{QB, D, nullptr, D, (size_t)(WS_K - WS_Q) / 2, attn_body::C2};
#ifndef NO_G1
        pg8::gemm_phase<pg8::EpiBf16<0>, pg8::StaticOrder, true, true>(ldsl + RING_OFF, g, S, E);
#endif
    }
    xcd_barrier(bar);

    {
        const attn_body::AttnTensors AT{(const attn_body::bf16*)QB, (const attn_body::bf16*)KB, (const attn_body::bf16*)VB, (attn_body::bf16*)QB, (const attn_body::bf16*)ZB, CC};
        const attn_body::StaticOrder S(G, bx);
#ifndef NO_ATTN
        attn_body::attn_phase<attn_body::StaticOrder>((char*)lds + RING_OFF, AT, S);
#endif

    }
    xcd_barrier(bar);

    {
        pg8::Gemm g{QB, W_FOUT, M, D, D}; pg8::StaticOrder S; S.init(M, D, G, bx);
        pg8::EpiResid E{x, hres, KB};
#ifndef NO_G2
        pg8::gemm_phase<pg8::EpiResid, pg8::StaticOrder, true, true>(ldsl + RING_OFF, g, S, E);
#endif
        pg8::Gemm g2{PB0, W_UP0, M, D, PLE}; pg8::StaticOrder S2; S2.init(M, D, G, bx);
        pg8::EpiBf16<0> E2{VB, D, nullptr, 0, 0, 1.f};
#ifndef NO_G3
        pg8::gemm_phase<pg8::EpiBf16<0>, pg8::StaticOrder, true, true>(ldsl + RING_OFF, g2, S2, E2);
#endif
    }
    xcd_barrier(bar);

    {
        pg8::Gemm g{KB, W_G0, M, D, D}; pg8::StaticOrder S; S.init(M, D, G, bx);
        pg8::EpiGate E{hres, VB, A1, dil_norm, SS};
#ifndef NO_G4
        pg8::gemm_phase<pg8::EpiGate, pg8::StaticOrder, true, true>(ldsl + RING_OFF, g, S, E);
#endif
    }
    xcd_barrier(bar);

    for (int b = 0; b < BATCH; ++b) {
        {
            pg8::Gemm g{A1 + (size_t)b * SEQ * D, W_DIN, SEQ, DIL_IN, D}; pg8::StaticOrder S; S.init(SEQ, DIL_IN, G, bx);
            pg8::EpiIn1 E{Q1, K1, V1, Z1, SS + (size_t)b * SEQ * 16, C2D, RMS_EPS};
#ifndef NO_G5
            pg8::gemm_phase<pg8::EpiIn1, pg8::StaticOrder, true, true>(ldsl + RING_OFF, g, S, E);
#endif
        }
        xcd_barrier(bar);
#ifndef NO_DIL
        dil::dil_phase((char*)lds + RING_OFF, Q1, K1, V1, LSE, G, bx);
#endif

        xcd_barrier(bar);
        FRESH_TID();
        for (int t = gw; t < SEQ; t += NGW) {
#pragma unroll
            for (int part = 0; part < 2; ++part) { const int c = part * 512 + 8 * lane, h = c >> 7;
                const float l0 = LSE[((size_t)0 * SEQ + t) * 8 + h], l1 = LSE[((size_t)1 * SEQ + t) * 8 + h], l2 = LSE[((size_t)2 * SEQ + t) * 8 + h];
                const float mx = fmaxf(l0, fmaxf(l1, l2)); float w0 = __builtin_amdgcn_exp2f(l0 - mx), w1 = __builtin_amdgcn_exp2f(l1 - mx), w2 = __builtin_amdgcn_exp2f(l2 - mx);
                const float inv = 1.0f / (w0 + w1 + w2); w0 *= inv; w1 *= inv; w2 *= inv;
                const v4u o0 = *(const GAS v4u*)(Q1 + (size_t)t * 3072 + c), o1 = *(const GAS v4u*)(Q1 + (size_t)t * 3072 + 1024 + c), o2 = *(const GAS v4u*)(Q1 + (size_t)t * 3072 + 2048 + c);
                const v4u zz = *(const GAS v4u*)(Z1 + (size_t)t * D + c); v4u r;
#define MRG(f) { const float e0 = w0 * pg8::bf_lo(o0.f) + w1 * pg8::bf_lo(o1.f) + w2 * pg8::bf_lo(o2.f), e1 = w0 * pg8::bf_hi(o0.f) + w1 * pg8::bf_hi(o1.f) + w2 * pg8::bf_hi(o2.f); \
                 const float z0 = pg8::bf_lo(zz.f), z1 = pg8::bf_hi(zz.f); r.f = pk2(e0 * z0 * pg8::sigmoid_f(z0), e1 * z1 * pg8::sigmoid_f(z1)); }
                MRG(x) MRG(y) MRG(z) MRG(w)
#undef MRG
                *(GAS v4u*)(A2 + ((size_t)b * SEQ + t) * D + c) = r; }
        }
        xcd_barrier(bar);
    }

    {
        bf16* const H3B = (bf16*)(ws + WS_H3B); bf16* const U1 = (bf16*)(ws + WS_U1);
        pg8::Gemm g{A2, W_DOUT, M, D, D}; pg8::StaticOrder S; S.init(M, D, G, bx);
        pg8::EpiResid E{hres, hres, H3B};
#ifndef NO_G6
        pg8::gemm_phase<pg8::EpiResid, pg8::StaticOrder, true, true>(ldsl + RING_OFF, g, S, E);
#endif
        pg8::Gemm g2{PB1, W_UP1, M, D, PLE}; pg8::StaticOrder S2; S2.init(M, D, G, bx);
        pg8::EpiBf16<0> E2{U1, D, nullptr, 0, 0, 1.f};
#ifndef NO_G7
        pg8::gemm_phase<pg8::EpiBf16<0>, pg8::StaticOrder, true, true>(ldsl + RING_OFF, g2, S2, E2);
#endif
        xcd_barrier(bar);
        pg8::Gemm g3{H3B, W_G1, M, D, D}; pg8::StaticOrder S3; S3.init(M, D, G, bx);
        pg8::EpiGate E3{hres, U1, nullptr, nullptr, nullptr};
#ifndef NO_G8
        pg8::gemm_phase<pg8::EpiGate, pg8::StaticOrder, true, true>(ldsl + RING_OFF, g3, S3, E3);
#endif
    }
    xcd_barrier(bar);

    {
        FRESH_TID();
        f32x4 g4[4];
#pragma unroll
        for (int j = 0; j < 4; ++j) g4[j] = *(const GAS f32x4*)(final_norm + 4 * lane + 256 * j);
        for (int m = gw; m < M; m += NGW) {
            f32x4 v[4]; float s2 = 0.f; GAS f32x4* row = (GAS f32x4*)(hres + (size_t)m * D) + lane;
#pragma unroll
            for (int j = 0; j < 4; ++j) { v[j] = row[64 * j]; s2 += (v[j].x * v[j].x + v[j].y * v[j].y) + (v[j].z * v[j].z + v[j].w * v[j].w); }
            const float rstd = 1.0f / sqrtf(wave_sum(s2) * (1.f / D) + RMS_EPS);
#pragma unroll
            for (int j = 0; j < 4; ++j) row[64 * j] = v[j] * rstd * g4[j];
        }
    }
}

extern "C" void kernel_launch(void* const* d_in, const int* in_sizes, int n_in, void* d_out, int out_size, void* d_ws, size_t ws_size, hipStream_t stream) {
    static int grid = 0;
    if (grid == 0) {
        if (n_in != 12 || in_sizes[0] != M * D || out_size != M * D || ws_size < WS_END) { fprintf(stderr, "kernel_launch: unexpected shapes (n_in %d, in0 %d, out %d, ws %zu); nothing launched\n", n_in, n_in > 0 ? in_sizes[0] : -1, out_size, ws_size); grid = -1; return; }
        int dev = 0, cus = 0, per_cu = 0;
        if (hipGetDevice(&dev) != hipSuccess || hipDeviceGetAttribute(&cus, hipDeviceAttributeMultiprocessorCount, dev) != hipSuccess) { grid = -1; return; }
        if (hipFuncSetAttribute((const void*)trunk_fwd, hipFuncAttributeMaxDynamicSharedMemorySize, LDS_BYTES) != hipSuccess) { fprintf(stderr, "kernel_launch: hipFuncSetAttribute failed\n"); grid = -1; return; }
        if (hipOccupancyMaxActiveBlocksPerMultiprocessor(&per_cu, (const void*)trunk_fwd, NWAVES * 64, LDS_BYTES) != hipSuccess || per_cu < 1) { fprintf(stderr, "kernel_launch: occupancy query says %d\n", per_cu); per_cu = 1; }
        (void)hipGetLastError();
        grid = cus;
        if (grid != 256) fprintf(stderr, "kernel_launch: %d CUs; the one-unit-per-CU GEMM phases assume 256\n", grid);
    }
    if (grid < 0) return;
    (void)hipMemsetAsync((char*)d_ws + WS_CTL, 0, CTL_ZERO_BYTES, stream);
    Args a{};
    for (int i = 0; i < 12; ++i) a.in[i] = (const float*)d_in[i];
    a.out = (float*)d_out; a.ws = (unsigned char*)d_ws;
    void* kargs[] = {&a};
    const hipError_t le = hipLaunchCooperativeKernel((const void*)trunk_fwd, dim3(grid), dim3(NWAVES * 64), kargs, LDS_BYTES, stream);
    if (le != hipSuccess) fprintf(stderr, "kernel_launch: cooperative launch failed: %s (grid %d)\n", hipGetErrorName(le), grid);
}
```

```cpp
#include <hip/hip_cooperative_groups.h>
#include <hip/hip_runtime.h>
#include <cstdio>
#include <cstdint>
__device__ __forceinline__ int lane_id_() { return (int)__builtin_amdgcn_mbcnt_hi(~0u, __builtin_amdgcn_mbcnt_lo(~0u, 0u)); }
template <int K> __device__ __forceinline__ float shx(float v) { static_assert(K >= 1 && K < 32, "shx: xor within a 32-lane half"); return __uint_as_float((unsigned)__builtin_amdgcn_ds_swizzle((int)__float_as_uint(v), 0x1f | (K << 10))); }
__device__ __forceinline__ float sum32(float v) { auto r = __builtin_amdgcn_permlane32_swap(__float_as_uint(v), __float_as_uint(v), false, false); return __uint_as_float(r[0]) + __uint_as_float(r[1]); }
__device__ __forceinline__ float max32(float v) { auto r = __builtin_amdgcn_permlane32_swap(__float_as_uint(v), __float_as_uint(v), false, false); return fmaxf(__uint_as_float(r[0]), __uint_as_float(r[1])); }
__device__ __forceinline__ float wave_sum(float v) { v += shx<1>(v); v += shx<2>(v); v += shx<4>(v); v += shx<8>(v); v += shx<16>(v); return sum32(v); }
namespace pg8 {
#define PG8_LAS __attribute__((address_space(3)))
typedef unsigned short bf16_t;
typedef short bf16x8 __attribute__((ext_vector_type(8)));
typedef float f32x4 __attribute__((ext_vector_type(4)));
typedef unsigned u32x4 __attribute__((ext_vector_type(4)));
constexpr int BM = 256, BK = 64, HALF = 128, HTB = HALF * BK * 2  , STAGE_BYTES = 8 * HTB, NXCD = 8, WGM = 8;

__host__ __device__ __forceinline__ int lds_byte(int r, int c) { const int st = (r >> 4) * 2 + (c >> 5), rr = r & 15, cc = c & 31, ob = rr * 64 + cc * 2; return st * 1024 + (ob ^ (((ob >> 9) & 1) << 5)); }
__host__ __device__ __forceinline__ void stage_rc(int b, int& R, int& C) { const int st = b / 1024, sb = b % 1024, swz = sb ^ (((sb >> 9) & 1) << 5); R = (st >> 1) * 16 + swz / 64; C = (st & 1) * 32 + (swz % 64) / 2; }
__host__ __device__ __forceinline__ int perm32(int rho) { const int n = rho >> 4, i = rho & 15; return 8 * (i >> 2) + 4 * n + (i & 3); }

struct Unit { int pm, pn; };
struct Gemm { const bf16_t* A; const bf16_t* Bt; int M, N, K; };

struct StaticOrder {
    int nM, nN, nwg, G, c;
    __host__ __device__ void init(int M, int N, int G_, int c_) { nM = M / BM; nN = N / BM; nwg = nM * nN; G = G_; c = c_; }
    __host__ __device__ bool next(int i, Unit& u) const {
        const long L = (long)i * G + c; if (L >= nwg) return false;
        int wgid = (int)L; { const int q = nwg / NXCD, r = nwg % NXCD, xcd = wgid % NXCD, off = wgid / NXCD; wgid = (xcd < r ? xcd * (q + 1) : r * (q + 1) + (xcd - r) * q) + off; }
        const int nig = WGM * nN, gid = wgid / nig, fm = gid * WGM, gsz = (nM - fm) < WGM ? (nM - fm) : WGM;
        u.pm = fm + ((wgid % nig) % gsz); u.pn = (wgid % nig) / gsz; return true;
    }
    __device__ __forceinline__ void a_ready(const Unit&) const {}
    __device__ __forceinline__ void done(const Unit&) const {}
};

__device__ __forceinline__ unsigned cvt_pk_bf16(float lo, float hi) { unsigned r; asm volatile("v_cvt_pk_bf16_f32 %0, %1, %2" : "=v"(r) : "v"(lo), "v"(hi)); return r; }
typedef float f32x2 __attribute__((ext_vector_type(2)));
__device__ __forceinline__ f32x2 gelu_pk(f32x2 v) {
    const f32x2 av = __builtin_elementwise_abs(v), d = av * 0.2316418882f + 1.0f;
    f32x2 t; t.x = __builtin_amdgcn_rcpf(d.x); t.y = __builtin_amdgcn_rcpf(d.y);
    f32x2 q = t * 0.5307027145f + (-0.7265760135f); q = q * t + 0.7107068705f; q = q * t + (-0.142248368f); q = q * t + 0.127414796f; q = q * t;
    const f32x2 s = (v * v) * (-0.72134752044f);
    f32x2 e; e.x = __builtin_amdgcn_exp2f(s.x); e.y = __builtin_amdgcn_exp2f(s.y);
    const f32x2 m = v * (q * e), r = v - m;
    f32x2 o; o.x = v.x < 0.f ? m.x : r.x; o.y = v.y < 0.f ? m.y : r.y; return o;
}

template <int ACT  > struct EpiBf16 {
    static constexpr bool PERM = true, AFTER_DRAIN = false; static_assert(ACT == 0 || ACT == 1, "EpiBf16: ACT is 0 (none) or 1 (gelu_pk)");
    bf16_t* O; int ldc; const float* bias; int split_cols; size_t split_stride; float scale0;
    __device__ __forceinline__ void operator()(const f32x4 (&acc)[2][2][4][2], const Unit& u, int wr, int wc, int fr, int fq) const {
        const int row0 = u.pm * BM + wr * 64 + fr; int colt = u.pn * BM; bf16_t* base = O;
        float sc = 1.f; if (split_cols) { const int t = colt / split_cols; base += (size_t)t * split_stride; colt -= t * split_cols; if (t == 0) sc = scale0; }
        const int col0 = colt + wc * 32 + 8 * fq, bcol0 = u.pn * BM + wc * 32 + 8 * fq;
        f32x4 bv[2][2];
#pragma unroll
        for (int bj = 0; bj < 2; ++bj)
#pragma unroll
            for (int n = 0; n < 2; ++n) bv[bj][n] = bias ? *(const f32x4*)(bias + bcol0 + bj * HALF + 4 * n) : (f32x4){0.f, 0.f, 0.f, 0.f};
#pragma unroll
        for (int ai = 0; ai < 2; ++ai)
#pragma unroll
            for (int m = 0; m < 4; ++m) { bf16_t* rowp = base + (size_t)(row0 + ai * HALF + m * 16) * ldc + col0;
#pragma unroll
                for (int bj = 0; bj < 2; ++bj) { f32x4 v0 = acc[ai][bj][m][0] + bv[bj][0], v1 = acc[ai][bj][m][1] + bv[bj][1];
                    if (ACT == 1) { f32x2 a = gelu_pk((f32x2){v0[0], v0[1]}), b = gelu_pk((f32x2){v0[2], v0[3]}), c = gelu_pk((f32x2){v1[0], v1[1]}), d = gelu_pk((f32x2){v1[2], v1[3]});
                        v0 = (f32x4){a.x, a.y, b.x, b.y}; v1 = (f32x4){c.x, c.y, d.x, d.y}; }
                    v0 = v0 * sc; v1 = v1 * sc; u32x4 w; w.x = cvt_pk_bf16(v0[0], v0[1]); w.y = cvt_pk_bf16(v0[2], v0[3]); w.z = cvt_pk_bf16(v1[0], v1[1]); w.w = cvt_pk_bf16(v1[2], v1[3]);
                    *(u32x4*)(rowp + bj * HALF) = w; } }
    }
};

__device__ __forceinline__ u32x4 pack8(const f32x4& v0, const f32x4& v1) { u32x4 w; w.x = cvt_pk_bf16(v0[0], v0[1]); w.y = cvt_pk_bf16(v0[2], v0[3]); w.z = cvt_pk_bf16(v1[0], v1[1]); w.w = cvt_pk_bf16(v1[2], v1[3]); return w; }
__device__ __forceinline__ float bf_lo(unsigned w) { return __uint_as_float(w << 16); }
__device__ __forceinline__ float bf_hi(unsigned w) { return __uint_as_float(w & 0xffff0000u); }
__device__ __forceinline__ float sigmoid_f(float x) { return __builtin_amdgcn_rcpf(1.0f + __builtin_amdgcn_exp2f(-1.4426950408889634f * x)); }

struct EpiFoxIn {
    static constexpr bool PERM = true, AFTER_DRAIN = false;
    bf16_t* O; size_t stride; float c2; unsigned* nm;
    __device__ __forceinline__ void operator()(const f32x4 (&acc)[2][2][4][2], const Unit& u, int wr, int wc, int fr, int fq) const {
        const int t = u.pn >> 2; bf16_t* base = O + (size_t)t * stride; const float sc = t == 0 ? c2 : 1.f;
        const int row0 = u.pm * BM + wr * 64 + fr, col0 = (u.pn & 3) * BM + wc * 32 + 8 * fq;
        float mx0 = 0.f, mx1 = 0.f;
#pragma unroll
        for (int ai = 0; ai < 2; ++ai)
#pragma unroll
            for (int m = 0; m < 4; ++m) { bf16_t* rowp = base + (size_t)(row0 + ai * HALF + m * 16) * 1024 + col0;
#pragma unroll
                for (int bj = 0; bj < 2; ++bj) { const f32x4 v0 = acc[ai][bj][m][0] * sc, v1 = acc[ai][bj][m][1] * sc;
                    *(u32x4*)(rowp + bj * HALF) = pack8(v0, v1);
                    if (t < 2) { float sq = (v0[0] * v0[0] + v0[1] * v0[1]) + (v0[2] * v0[2] + v0[3] * v0[3]) + (v1[0] * v1[0] + v1[1] * v1[1]) + (v1[2] * v1[2] + v1[3] * v1[3]);
                        sq += shx<16>(sq); sq = sum32(sq); if (bj == 0) mx0 = fmaxf(mx0, sq); else mx1 = fmaxf(mx1, sq); } } }
        if (t < 2) {
            { mx0 = fmaxf(mx0, shx<1>(mx0)); mx1 = fmaxf(mx1, shx<1>(mx1)); mx0 = fmaxf(mx0, shx<2>(mx0)); mx1 = fmaxf(mx1, shx<2>(mx1)); mx0 = fmaxf(mx0, shx<4>(mx0)); mx1 = fmaxf(mx1, shx<4>(mx1)); mx0 = fmaxf(mx0, shx<8>(mx0)); mx1 = fmaxf(mx1, shx<8>(mx1)); }
            if (fr == 0 && fq == 0) { const int b = u.pm >> 5, hd = (u.pn & 3) * 4 + (wc >> 1); unsigned* p = nm + (((b * 2 + t) * 16 + hd) * 2 + (wc & 1));
                atomicMax(p, __float_as_uint(mx0 * 1.02f)); atomicMax(p + 4, __float_as_uint(mx1 * 1.02f)); } }
    }
};
struct EpiResid {
    static constexpr bool PERM = true, AFTER_DRAIN = false;
    const float* base; float* out; bf16_t* hb;
    __device__ __forceinline__ void operator()(const f32x4 (&acc)[2][2][4][2], const Unit& u, int wr, int wc, int fr, int fq) const {
        const int row0 = u.pm * BM + wr * 64 + fr, col0 = u.pn * BM + wc * 32 + 8 * fq;
#pragma unroll
        for (int ai = 0; ai < 2; ++ai)
#pragma unroll
            for (int m = 0; m < 4; ++m) { const size_t off = (size_t)(row0 + ai * HALF + m * 16) * 1024 + col0;
#pragma unroll
                for (int bj = 0; bj < 2; ++bj) { const f32x4 b0 = *(const f32x4*)(base + off + bj * HALF), b1 = *(const f32x4*)(base + off + bj * HALF + 4);
                    const f32x4 v0 = acc[ai][bj][m][0] + b0, v1 = acc[ai][bj][m][1] + b1;
                    *(f32x4*)(out + off + bj * HALF) = v0; *(f32x4*)(out + off + bj * HALF + 4) = v1;
                    *(u32x4*)(hb + off + bj * HALF) = pack8(v0, v1); }
                asm volatile("" ::: "memory"); }
    }
};
struct EpiGate {
    static constexpr bool PERM = true, AFTER_DRAIN = false;
    float* h; const bf16_t* U; bf16_t* a1; const float* g; float* ss;
    __device__ __forceinline__ void operator()(const f32x4 (&acc)[2][2][4][2], const Unit& u, int wr, int wc, int fr, int fq) const {
        const int row0 = u.pm * BM + wr * 64 + fr, col0 = u.pn * BM + wc * 32 + 8 * fq;
        f32x4 gv[2][2];
#pragma unroll
        for (int bj = 0; bj < 2; ++bj)
#pragma unroll
            for (int n = 0; n < 2; ++n) gv[bj][n] = a1 ? *(const f32x4*)(g + col0 + bj * HALF + 4 * n) : (f32x4){0.f, 0.f, 0.f, 0.f};
#pragma unroll
        for (int ai = 0; ai < 2; ++ai)
#pragma unroll
            for (int m = 0; m < 4; ++m) { const int row = row0 + ai * HALF + m * 16; const size_t off = (size_t)row * 1024 + col0; float sq = 0.f;
#pragma unroll
                for (int bj = 0; bj < 2; ++bj) { const f32x4 h0 = *(const f32x4*)(h + off + bj * HALF), h1 = *(const f32x4*)(h + off + bj * HALF + 4);
                    const u32x4 uu = *(const u32x4*)(U + off + bj * HALF);
                    const f32x4 a0 = acc[ai][bj][m][0], a1v = acc[ai][bj][m][1];
                    f32x4 v0, v1;
                    v0[0] = h0[0] + bf_lo(uu.x) * sigmoid_f(a0[0]); v0[1] = h0[1] + bf_hi(uu.x) * sigmoid_f(a0[1]);
                    v0[2] = h0[2] + bf_lo(uu.y) * sigmoid_f(a0[2]); v0[3] = h0[3] + bf_hi(uu.y) * sigmoid_f(a0[3]);
                    v1[0] = h1[0] + bf_lo(uu.z) * sigmoid_f(a1v[0]); v1[1] = h1[1] + bf_hi(uu.z) * sigmoid_f(a1v[1]);
                    v1[2] = h1[2] + bf_lo(uu.w) * sigmoid_f(a1v[2]); v1[3] = h1[3] + bf_hi(uu.w) * sigmoid_f(a1v[3]);
                    *(f32x4*)(h + off + bj * HALF) = v0; *(f32x4*)(h + off + bj * HALF + 4) = v1;
                    if (a1) { *(u32x4*)(a1 + off + bj * HALF) = pack8(v0 * gv[bj][0], v1 * gv[bj][1]);
                        sq += (v0[0] * v0[0] + v0[1] * v0[1]) + (v0[2] * v0[2] + v0[3] * v0[3]) + (v1[0] * v1[0] + v1[1] * v1[1]) + (v1[2] * v1[2] + v1[3] * v1[3]); } }
                if (a1) { sq += shx<16>(sq); sq = sum32(sq); if (fq == 0) ss[(size_t)row * 16 + u.pn * 4 + wc] = sq; }
                asm volatile("" ::: "memory"); }
    }
};
struct EpiIn1 {
    static constexpr bool PERM = true, AFTER_DRAIN = false;
    bf16_t* q; bf16_t* k; bf16_t* v; bf16_t* z; const float* ss; float c2d, eps;
    __device__ __forceinline__ void operator()(const f32x4 (&acc)[2][2][4][2], const Unit& u, int wr, int wc, int fr, int fq) const {
        const int row0 = u.pm * BM + wr * 64 + fr; const int t = u.pn / 12;
        bf16_t* base = t == 0 ? q : t == 1 ? k : t == 2 ? v : z; const int ldc = t < 3 ? 3072 : 1024; const float sc = t == 0 ? c2d : 1.f;
        const int col0 = (u.pn - 12 * t) * BM + wc * 32 + 8 * fq;
#pragma unroll
        for (int ai = 0; ai < 2; ++ai)
#pragma unroll
            for (int m = 0; m < 4; ++m) { const int row = row0 + ai * HALF + m * 16;
                const f32x4* sp = (const f32x4*)(ss + (size_t)row * 16); const f32x4 s0 = sp[0], s1 = sp[1], s2 = sp[2], s3 = sp[3];
                const float tot = ((s0[0] + s0[1]) + (s0[2] + s0[3])) + ((s1[0] + s1[1]) + (s1[2] + s1[3])) + ((s2[0] + s2[1]) + (s2[2] + s2[3])) + ((s3[0] + s3[1]) + (s3[2] + s3[3]));
                const float rs = __builtin_amdgcn_rsqf(tot * (1.0f / 1024.0f) + eps) * sc;
                bf16_t* rowp = base + (size_t)row * ldc + col0;
#pragma unroll
                for (int bj = 0; bj < 2; ++bj) *(u32x4*)(rowp + bj * HALF) = pack8(acc[ai][bj][m][0] * rs, acc[ai][bj][m][1] * rs);
                asm volatile("" ::: "memory"); }
    }
};

template <class Epi, class Sched, bool ALIGN_EPI = false, bool SP2 = false>
__device__ __forceinline__ void gemm_phase(PG8_LAS unsigned char* lds, const Gemm g, const Sched& S, const Epi& E, const int wave_id) {
    int tid_ = wave_id * 64 + lane_id_(); asm volatile("" : "+v"(tid_));
    const int tid = tid_, wid = __builtin_amdgcn_readfirstlane(tid >> 6), lane = tid & 63, wr = wid >> 2, wc = wid & 3, fr = lane & 15, fq = lane >> 4;
    const int K = g.K, nt = K / BK;
    unsigned voffA[2], voffB[2];
#pragma unroll
    for (int i = 0; i < 2; ++i) { int R, C; stage_rc(tid * 16 + i * 8192, R, C); const int Rb = Epi::PERM ? ((R & ~31) + perm32(R & 31)) : R;
        voffA[i] = (unsigned)(R * K + C) * 2u; voffB[i] = (unsigned)(Rb * K + C) * 2u; }
    const size_t kstep = (size_t)(BK * 2);
    const size_t hstep = (size_t)HALF * K * 2;
    const size_t tstep = 2 * hstep;
    const unsigned ldsw = (unsigned)wid * 1024u;
    const int aoff = lds_byte(wr * 64 + fr, fq * 8), boff = lds_byte(wc * 32 + fr, fq * 8);
#define PG8_SA(b, h) (((b) * 2 + (h)) * HTB)
#define PG8_SB(b, h) ((4 + (b) * 2 + (h)) * HTB)
#define PG8_STAGE(bufoff, gbase, voff) do { _Pragma("unroll") for (int _i = 0; _i < 2; ++_i) \
        __builtin_amdgcn_global_load_lds((const unsigned*)((const char*)(gbase) + (voff)[_i]), (PG8_LAS unsigned*)(lds + (bufoff) + ldsw + _i * 8192), 16, 0, 0); } while (0)
#define PG8_LDA(dst, b, h) do { _Pragma("unroll") for (int m = 0; m < 4; ++m) _Pragma("unroll") for (int k = 0; k < 2; ++k) dst[m][k] = *(const PG8_LAS bf16x8*)(lds + PG8_SA(b, h) + aoff + m * 2048 + k * 1024); } while (0)
#define PG8_LDB(dst, b, h) do { _Pragma("unroll") for (int n = 0; n < 2; ++n) _Pragma("unroll") for (int k = 0; k < 2; ++k) dst[n][k] = *(const PG8_LAS bf16x8*)(lds + PG8_SB(b, h) + boff + n * 2048 + k * 1024); } while (0)
#define PG8_MMA(ai, bj, At, Bt) do { __builtin_amdgcn_s_setprio(1); _Pragma("unroll") for (int m = 0; m < 4; ++m) _Pragma("unroll") for (int n = 0; n < 2; ++n) _Pragma("unroll") for (int k = 0; k < 2; ++k) \
        acc[ai][bj][m][n] = __builtin_amdgcn_mfma_f32_16x16x32_bf16(Bt[n][k], At[m][k], acc[ai][bj][m][n], 0, 0, 0); __builtin_amdgcn_s_setprio(0); } while (0)
#define PG8_WAIT_V(n) asm volatile("s_waitcnt vmcnt(" #n ")" ::: "memory")
#define PG8_WAIT_L(n) asm volatile("s_waitcnt lgkmcnt(" #n ")" ::: "memory")
#define PG8_BAR __builtin_amdgcn_s_barrier()
#define PG8_SCHED __builtin_amdgcn_sched_barrier(0)
    Unit cur, nxt; int ui = 0;
    if (!S.next(0, cur)) return;
    f32x4 acc[2][2][4][2];
#pragma unroll
    for (int a = 0; a < 2; ++a)
#pragma unroll
        for (int b = 0; b < 2; ++b)
#pragma unroll
            for (int m = 0; m < 4; ++m)
#pragma unroll
                for (int n = 0; n < 2; ++n) acc[a][b][m][n] = (f32x4){0.f, 0.f, 0.f, 0.f};
    bf16x8 At[4][2], B0[2][2], B1[2][2];
    const char* cA = (const char*)g.A + (size_t)cur.pm * tstep; const char* cB = (const char*)g.Bt + (size_t)cur.pn * tstep;
    S.a_ready(cur);
    if constexpr (SP2) {
        PG8_STAGE(PG8_SB(0, 0), cB, voffB); PG8_STAGE(PG8_SB(0, 1), cB + hstep, voffB); PG8_STAGE(PG8_SA(0, 0), cA, voffA); PG8_STAGE(PG8_SA(0, 1), cA + hstep, voffA);
        if (wr == 1) PG8_BAR;
        PG8_WAIT_V(2); PG8_BAR;
        PG8_STAGE(PG8_SB(1, 0), cB + kstep, voffB); PG8_STAGE(PG8_SA(1, 0), cA + kstep, voffA); PG8_STAGE(PG8_SB(1, 1), cB + hstep + kstep, voffB);
        PG8_WAIT_V(6); PG8_BAR;
    } else {
        PG8_STAGE(PG8_SB(0, 0), cB, voffB); PG8_STAGE(PG8_SA(0, 0), cA, voffA); PG8_STAGE(PG8_SB(0, 1), cB + hstep, voffB); PG8_STAGE(PG8_SA(0, 1), cA + hstep, voffA);
        if (wr == 1) PG8_BAR;
        PG8_WAIT_V(4); PG8_BAR;
        PG8_STAGE(PG8_SB(1, 0), cB + kstep, voffB); PG8_STAGE(PG8_SA(1, 0), cA + kstep, voffA); PG8_STAGE(PG8_SB(1, 1), cB + hstep + kstep, voffB);
        PG8_WAIT_V(6); PG8_BAR;
    }
    for (;;) {
        const bool has_next = S.next(ui + 1, nxt);
        const char* nA = has_next ? (const char*)g.A + (size_t)nxt.pm * tstep : cA; const char* nB = has_next ? (const char*)g.Bt + (size_t)nxt.pn * tstep : cB;
        for (int t = 0; t < nt; t += 2) {
            const bool last = (t == nt - 2);
            const char* a1 = cA + (size_t)(t + 1) * kstep;
            const char* a2 = last ? nA : cA + (size_t)(t + 2) * kstep; const char* b2 = last ? nB : cB + (size_t)(t + 2) * kstep;
            const char* a3 = a2 + kstep; const char* b3 = b2 + kstep;
            if (last && has_next) S.a_ready(nxt);
            if constexpr (SP2) {
            PG8_LDB(B0, 0, 0); PG8_LDB(B1, 0, 1); PG8_SCHED; PG8_LDA(At, 0, 0); PG8_STAGE(PG8_SA(1, 1), a1 + hstep, voffA);
            PG8_WAIT_V(8); PG8_WAIT_L(0); PG8_BAR; PG8_MMA(0, 0, At, B0); PG8_MMA(0, 1, At, B1); PG8_BAR; PG8_SCHED;
            PG8_LDA(At, 0, 1); PG8_STAGE(PG8_SB(0, 0), b2, voffB); PG8_STAGE(PG8_SB(0, 1), b2 + hstep, voffB); PG8_STAGE(PG8_SA(0, 0), a2, voffA);
            PG8_WAIT_V(8); PG8_WAIT_L(0); PG8_BAR; PG8_MMA(1, 0, At, B0); PG8_MMA(1, 1, At, B1); PG8_BAR; PG8_SCHED;
            PG8_LDB(B0, 1, 0); PG8_LDB(B1, 1, 1); PG8_SCHED; PG8_LDA(At, 1, 0); PG8_STAGE(PG8_SA(0, 1), a2 + hstep, voffA);
            PG8_WAIT_V(8); PG8_WAIT_L(0); PG8_BAR; PG8_MMA(0, 0, At, B0); PG8_MMA(0, 1, At, B1); PG8_BAR; PG8_SCHED;
            PG8_LDA(At, 1, 1); PG8_STAGE(PG8_SB(1, 0), b3, voffB); PG8_STAGE(PG8_SB(1, 1), b3 + hstep, voffB); PG8_STAGE(PG8_SA(1, 0), a3, voffA);
            PG8_WAIT_V(8); PG8_WAIT_L(0); PG8_BAR; PG8_MMA(1, 0, At, B0); PG8_MMA(1, 1, At, B1); PG8_BAR; PG8_SCHED;
            } else {
            PG8_LDB(B0, 0, 0); PG8_SCHED; PG8_LDA(At, 0, 0); PG8_STAGE(PG8_SA(1, 1), a1 + hstep, voffA);
            PG8_WAIT_L(8); PG8_BAR; PG8_WAIT_L(0); PG8_MMA(0, 0, At, B0); PG8_BAR; PG8_SCHED;
            PG8_LDB(B1, 0, 1); PG8_STAGE(PG8_SB(0, 0), b2, voffB);
            PG8_BAR; PG8_WAIT_L(0); PG8_MMA(0, 1, At, B1); PG8_BAR;
            PG8_LDA(At, 0, 1); PG8_STAGE(PG8_SA(0, 0), a2, voffA);
            PG8_BAR; PG8_WAIT_L(0); PG8_MMA(1, 0, At, B0); PG8_BAR; PG8_SCHED;
            PG8_STAGE(PG8_SB(0, 1), b2 + hstep, voffB);
            PG8_WAIT_V(6); PG8_BAR; PG8_MMA(1, 1, At, B1); PG8_BAR;
            PG8_LDB(B0, 1, 0); PG8_SCHED; PG8_LDA(At, 1, 0); PG8_STAGE(PG8_SA(0, 1), a2 + hstep, voffA);
            PG8_WAIT_L(8); PG8_BAR; PG8_WAIT_L(0); PG8_MMA(0, 0, At, B0); PG8_BAR; PG8_SCHED;
            PG8_LDB(B1, 1, 1); PG8_STAGE(PG8_SB(1, 0), b3, voffB);
            PG8_BAR; PG8_WAIT_L(0); PG8_MMA(0, 1, At, B1); PG8_BAR;
            PG8_LDA(At, 1, 1); PG8_STAGE(PG8_SA(1, 0), a3, voffA);
            PG8_BAR; PG8_WAIT_L(0); PG8_MMA(1, 0, At, B0); PG8_BAR; PG8_SCHED;
            PG8_STAGE(PG8_SB(1, 1), b3 + hstep, voffB);
            PG8_WAIT_V(6); PG8_BAR; PG8_MMA(1, 1, At, B1); PG8_BAR;
            }
        }
        if constexpr (ALIGN_EPI) { if (wr == 0) PG8_BAR; }
        if constexpr (!Epi::AFTER_DRAIN) { E(acc, cur, wr, wc, fr, fq); S.done(cur); }
        if (!has_next) break;
#pragma unroll
        for (int a = 0; a < 2; ++a)
#pragma unroll
            for (int b = 0; b < 2; ++b)
#pragma unroll
                for (int m = 0; m < 4; ++m)
#pragma unroll
                    for (int n = 0; n < 2; ++n) acc[a][b][m][n] = (f32x4){0.f, 0.f, 0.f, 0.f};
        cur = nxt; cA = nA; cB = nB; ++ui;
        if constexpr (ALIGN_EPI) { if (wr == 1) PG8_BAR; }
    }
    PG8_WAIT_V(0);
    if constexpr (!ALIGN_EPI) { if (wr == 0) PG8_BAR; }
    PG8_BAR;
    if constexpr (Epi::AFTER_DRAIN) { E.fused(acc, cur, wr, wc, fr, fq, lds, wid, lane); S.done(cur); }
#undef PG8_SA
#undef PG8_SB
#undef PG8_STAGE
#undef PG8_LDA
#undef PG8_LDB
#undef PG8_MMA
#undef PG8_WAIT_V
#undef PG8_WAIT_L
#undef PG8_BAR
#undef PG8_SCHED
}
}
#include <hip/hip_bf16.h>
#include <cmath>
namespace attn_body {
using bf16=__hip_bfloat16;
using bf16x8=__attribute__((ext_vector_type(8)))short;
using s16x4=__attribute__((ext_vector_type(4)))short;
using f32x16=__attribute__((ext_vector_type(16)))float;
using u32x4=__attribute__((ext_vector_type(4)))unsigned;
constexpr int BATCH=2,NHEAD=16,SEQ=8192,D=64,DM=NHEAD*D;
constexpr int NW=8,QBLK=32,QB=QBLK*NW,KVBLK=64,NQB=SEQ/QB;
constexpr int ATTN_PITCH=DM, ATTN_UNIT_ROWS=QB;
__device__ __forceinline__ int crow(int r,int hi){return (r&3)+8*(r>>2)+4*hi;}
#define SBAR() __builtin_amdgcn_sched_barrier(0)
__device__ __forceinline__ void cmask(f32x16&p0,f32x16&p1,int jb,int qrel,int hi){
  const float NEG=-INFINITY; int kb=64*jb+4*hi;
  #pragma unroll
  for(int r=0;r<16;++r){int kv=kb+(r&3)+8*(r>>2); if(kv>qrel)p0[r]=NEG; if(kv+32>qrel)p1[r]=NEG;}
}

typedef float f32x4_t __attribute__((ext_vector_type(4)));
constexpr int NSLOT=3, SLOTB=8192;
constexpr int LDS_K=0, LDS_V=NSLOT*SLOTB, LDS_WS=2*NSLOT*SLOTB, LDS_OST=LDS_WS+NW*64*4, LDS_CT=LDS_OST+NW*4096, LDS_BYTES=LDS_CT+SEQ*4;
constexpr float C2=0.125f*1.4426950408889634f;
__device__ __forceinline__ void glds16(const void*gsrc,unsigned lds_dst){unsigned keep;
  asm volatile("s_mov_b32 %0, m0\n\ts_mov_b32 m0, %2\n\ts_nop 0\n\tglobal_load_lds_dwordx4 %1, off\n\ts_mov_b32 m0, %0":"=&s"(keep):"v"(gsrc),"s"(lds_dst):"memory");}
__device__ __forceinline__ float max3f(float a,float b,float c){float r;asm("v_max3_f32 %0, %1, %2, %3":"=v"(r):"v"(a),"v"(b),"v"(c));return r;}
__device__ __forceinline__ float max2f(float a,float b){float r;asm("v_max_f32_e32 %0, %1, %2":"=v"(r):"v"(a),"v"(b));return r;}
__device__ __forceinline__ float fadd_s(float a,float b){float r;asm("v_add_f32_e32 %0, %1, %2":"=v"(r):"v"(a),"v"(b));return r;}
__device__ __forceinline__ float fsub_s(float a,float b){float r;asm("v_sub_f32_e32 %0, %1, %2":"=v"(r):"v"(a),"v"(b));return r;}
typedef float f32x2_t __attribute__((ext_vector_type(2))); typedef __bf16 bf16x2_t __attribute__((ext_vector_type(2)));
__device__ __forceinline__ unsigned cvtpk_s(float lo,float hi){f32x2_t v={lo,hi};bf16x2_t b=__builtin_convertvector(v,bf16x2_t);return __builtin_bit_cast(unsigned,b);}
__device__ __forceinline__ float silu_f(float z){return z*__builtin_amdgcn_rcpf(1.0f+__builtin_amdgcn_exp2f(-1.4426950408889634f*z));}
__device__ __forceinline__ unsigned gate2(unsigned o,unsigned z){ const float o0=__uint_as_float(o<<16),o1=__uint_as_float(o&0xffff0000u),z0=__uint_as_float(z<<16),z1=__uint_as_float(z&0xffff0000u); return cvtpk_s(o0*silu_f(z0),o1*silu_f(z1)); }
#define WAIT_BAR(N) asm volatile("s_waitcnt vmcnt(" #N ") lgkmcnt(0)\n\ts_barrier":::"memory")

__device__ __forceinline__ void qkt(f32x16&p0,f32x16&p1,const char*Kslot,const bf16x8*qr,const f32x16&negm,int r32,int hi){
  const char*kb=Kslot+hi*1024+r32*16;
  #pragma unroll
  for(int d0=0;d0<4;++d0){
    const bf16x8 b0=*reinterpret_cast<const bf16x8*>(kb+d0*2048);
    const bf16x8 b1=*reinterpret_cast<const bf16x8*>(kb+d0*2048+512);
    if(d0==0){p0=__builtin_amdgcn_mfma_f32_32x32x16_bf16(b0,qr[0],negm,0,0,0);p1=__builtin_amdgcn_mfma_f32_32x32x16_bf16(b1,qr[0],negm,0,0,0);}
    else{p0=__builtin_amdgcn_mfma_f32_32x32x16_bf16(b0,qr[d0],p0,0,0,0);p1=__builtin_amdgcn_mfma_f32_32x32x16_bf16(b1,qr[d0],p1,0,0,0);}}
}
typedef __attribute__((address_space(3))) const char* lds_cptr;
typedef short v4i16_t __attribute__((ext_vector_type(4)));
__device__ __forceinline__ void kload8(bf16x8*kf,lds_cptr kp){
  kf[0]=*(const __attribute__((address_space(3))) bf16x8*)(kp);      kf[1]=*(const __attribute__((address_space(3))) bf16x8*)(kp+512);
  kf[2]=*(const __attribute__((address_space(3))) bf16x8*)(kp+2048); kf[3]=*(const __attribute__((address_space(3))) bf16x8*)(kp+2560);
  kf[4]=*(const __attribute__((address_space(3))) bf16x8*)(kp+4096); kf[5]=*(const __attribute__((address_space(3))) bf16x8*)(kp+4608);
  kf[6]=*(const __attribute__((address_space(3))) bf16x8*)(kp+6144); kf[7]=*(const __attribute__((address_space(3))) bf16x8*)(kp+6656);
}
__device__ __forceinline__ void kload2(bf16x8*kf,lds_cptr kp,int j){ kf[2*j]=*(const __attribute__((address_space(3))) bf16x8*)(kp+j*2048); kf[2*j+1]=*(const __attribute__((address_space(3))) bf16x8*)(kp+j*2048+512); }
__device__ __forceinline__ s16x4 vtr(lds_cptr p){ return __builtin_bit_cast(s16x4,__builtin_amdgcn_ds_read_tr16_b64_v4i16((__attribute__((address_space(3))) v4i16_t*)p)); }
__device__ __forceinline__ float rowmax(const f32x16&p0,const f32x16&p1){
  float a=max3f(p0[0],p0[1],p1[0]),b=max3f(p0[2],p0[3],p1[1]);a=max3f(a,p1[2],p1[3]);
  #pragma unroll
  for(int r=4;r<16;r+=4){a=max3f(a,p0[r],p0[r+1]);b=max3f(b,p0[r+2],p0[r+3]);a=max3f(a,p1[r],p1[r+1]);b=max3f(b,p1[r+2],p1[r+3]);}
  const float m=max2f(a,b);
  auto rr=__builtin_amdgcn_permlane32_swap(__float_as_uint(m),__float_as_uint(m),false,false);
  return max2f(__uint_as_float(rr[0]),__uint_as_float(rr[1]));
}
__device__ __forceinline__ void pv(f32x16*o,int vb,bf16x8 pa0,bf16x8 pa1,bf16x8 pa2,bf16x8 pa3){
  #pragma unroll
  for(int d0=0;d0<2;++d0){s16x4 lo[4],hi[4];
    #pragma unroll
    for(int ks=0;ks<4;++ks){
      asm volatile("ds_read_b64_tr_b16 %0,%1 offset:%c2":"=&v"(lo[ks]):"v"(vb),"i"(d0*4096+ks*1024):"memory");
      asm volatile("ds_read_b64_tr_b16 %0,%1 offset:%c2":"=&v"(hi[ks]):"v"(vb),"i"(d0*4096+ks*1024+512):"memory");}
    asm volatile("s_waitcnt lgkmcnt(0)":::"memory");SBAR();
    #define PK(k) (bf16x8){lo[k][0],lo[k][1],lo[k][2],lo[k][3],hi[k][0],hi[k][1],hi[k][2],hi[k][3]}
    o[d0]=__builtin_amdgcn_mfma_f32_32x32x16_bf16(pa0,PK(0),o[d0],0,0,0);
    o[d0]=__builtin_amdgcn_mfma_f32_32x32x16_bf16(pa1,PK(1),o[d0],0,0,0);
    o[d0]=__builtin_amdgcn_mfma_f32_32x32x16_bf16(pa2,PK(2),o[d0],0,0,0);
    o[d0]=__builtin_amdgcn_mfma_f32_32x32x16_bf16(pa3,PK(3),o[d0],0,0,0);
    #undef PK
  }
}

#ifndef ATTN_STORE16
#define ATTN_STORE16(p,v) (*(u32x4*)(p)=(v))
#endif
template<int THRL> __device__ __forceinline__ void attn_unit(int b,int h,int qb,const bf16*Q,const bf16*__restrict__ K,const bf16*__restrict__ V,bf16*O,const bf16*__restrict__ Zg,const float*__restrict__ Cg,const unsigned*NMp,char*shm,const int wave_id){
  int tid_=wave_id*64+lane_id_(); asm volatile("":"+v"(tid_)); const int tid=tid_,lane=tid&63,r32=lane&31,hi=lane>>5; const int wid=__builtin_amdgcn_readfirstlane(tid>>6);
  const long rowbase=(long)b*SEQ; const int q0=qb*QB;
  const bf16*Qw=Q+(rowbase+q0+wid*QBLK)*DM+h*D;
  const bf16*Kh=K+rowbase*DM+h*D,*Vh=V+rowbase*DM+h*D;
  const unsigned lds0=(unsigned)(uintptr_t)shm;
  float*wsf=(float*)(shm+LDS_WS)+wid*64;
  const bf16*ksrc=Kh+(long)lane*DM+wid*8;
  const bf16*vsrc=Vh+(long)(16*(wid&3)+(lane>>2))*DM+(wid>>2)*32+(lane&3)*8;
  const unsigned kdst=lds0+LDS_K+wid*1024, vdst=lds0+LDS_V+wid*1024;
  #define TILE(j) (NT-1-(j))
  #define DMA_K(t,slot) glds16(ksrc+(long)TILE(t)*KVBLK*DM,(unsigned)__builtin_amdgcn_readfirstlane(kdst+(slot)))
  #define DMA_V(t,slot) glds16(vsrc+(long)TILE(t)*KVBLK*DM,(unsigned)__builtin_amdgcn_readfirstlane(vdst+(slot)))
  const int vb0=(int)(lds0+LDS_V)+((lane>>4)&1)*32+(lane&3)*8+(4*hi+((lane&15)>>2))*64;
  const char*Kbase=shm+LDS_K; bf16x8 kf[8];
  const lds_cptr shm3=(lds_cptr)shm; const lds_cptr kp0=shm3+LDS_K+hi*1024+r32*16; const lds_cptr vp0=shm3+LDS_V+((lane>>4)&1)*32+(lane&3)*8+(4*hi+((lane&15)>>2))*64;
  const int NT=(q0+QB)/KVBLK;
  DMA_K(0,0);DMA_V(0,0);DMA_K(1,SLOTB);
  bf16x8 qr[4];
  #pragma unroll
  for(int d0=0;d0<4;++d0)qr[d0]=*reinterpret_cast<const bf16x8*>(&Qw[(long)r32*DM+d0*16+hi*8]);
  float mhat=0.f,l_reg=0.f;f32x16 o[2];o[0]=f32x16{};o[1]=f32x16{};f32x16 negm=f32x16{};asm volatile("":"+v"(negm));
  const int qrel=wid*QBLK+r32;
  #define CMASK(P0,P1,t) do{int jb_=3-(t); if(jb_>=0)cmask(P0,P1,jb_,qrel,hi);}while(0)
  #define CDEC(P0,P1,t) do{ const lds_f4ptr cb_=(lds_f4ptr)(ctab+64*TILE(t)+4*hi); \
    _Pragma("unroll") for(int g_=0;g_<4;++g_){ const f32x4_t a_=cb_[2*g_], b_=cb_[8+2*g_]; \
      P0[4*g_]-=a_[0];P0[4*g_+1]-=a_[1];P0[4*g_+2]-=a_[2];P0[4*g_+3]-=a_[3]; P1[4*g_]-=b_[0];P1[4*g_+1]-=b_[1];P1[4*g_+2]-=b_[2];P1[4*g_+3]-=b_[3]; } }while(0)
  bool resc=false;
  #define START(P0,P1) do{ const float rm=rowmax(P0,P1); resc=false; \
    { const float dl=(rm==-INFINITY)?0.f:rm; mhat=fadd_s(mhat,dl); \
      _Pragma("unroll") for(int r=0;r<16;++r){P0[r]=fsub_s(P0[r],dl);P1[r]=fsub_s(P1[r],dl);} \
      _Pragma("unroll") for(int r=0;r<16;++r)negm[r]=-mhat; asm volatile("":"+v"(negm)); } \
    _Pragma("unroll") for(int r=0;r<16;++r)P0[r]=__builtin_amdgcn_exp2f(P0[r]); }while(0)
  #define RESC() do{ if(resc){ asm volatile("s_waitcnt lgkmcnt(0)":::"memory"); \
      _Pragma("unroll") for(int d_=0;d_<2;++d_) _Pragma("unroll") for(int r=0;r<16;++r)o[d_][r]*=wsf[crow(r,hi)]; } }while(0)
  f32x16 pA0,pA1,pB0,pB1;
  int sl_prev=0,sl_cur=0,sl_next=SLOTB;
  #define ROT() do{sl_prev=sl_cur;sl_cur=sl_next;sl_next=(sl_next==(NSLOT-1)*SLOTB)?0:sl_next+SLOTB;}while(0)
  DMA_K(2,2*SLOTB);
  typedef __attribute__((address_space(3))) float* lds_fptr; typedef __attribute__((address_space(3))) const f32x4_t* lds_f4ptr;
  const lds_fptr ctab=(lds_fptr)(shm3+LDS_CT);
  { const float*cg=Cg+(long)(b*NHEAD+h)*SEQ; const float cref=cg[q0];
    for(int i=tid*4;i<q0+QB;i+=NW*64*4){ f32x4_t v=*(const f32x4_t*)(cg+i); v[0]-=cref;v[1]-=cref;v[2]-=cref;v[3]-=cref; *(__attribute__((address_space(3))) f32x4_t*)(ctab+i)=v; } }
  float thr; { const unsigned*nm=NMp+((b*2)*NHEAD+h)*2; const float qs=__uint_as_float(__hip_atomic_load(nm,__ATOMIC_RELAXED,__HIP_MEMORY_SCOPE_AGENT))+__uint_as_float(__hip_atomic_load(nm+1,__ATOMIC_RELAXED,__HIP_MEMORY_SCOPE_AGENT)),
      ks=__uint_as_float(__hip_atomic_load(nm+2*NHEAD,__ATOMIC_RELAXED,__HIP_MEMORY_SCOPE_AGENT))+__uint_as_float(__hip_atomic_load(nm+2*NHEAD+1,__ATOMIC_RELAXED,__HIP_MEMORY_SCOPE_AGENT)); thr=48.f+2.02f*sqrtf(qs*ks); }
  WAIT_BAR(3);
  int NTE; { const int tl0=NT-5-lane, tl1=tl0-64; const float c0_=tl0>=0?ctab[64*tl0+63]:3.0e38f, c1_=tl1>=0?ctab[64*tl1+63]:3.0e38f;
    NTE=4+__popcll(__ballot(c0_<=thr))+__popcll(__ballot(c1_<=thr)); NTE+=NTE&1; NTE=__builtin_amdgcn_readfirstlane(NTE); }
  mhat=-ctab[q0+wid*QBLK+r32];
  _Pragma("unroll") for(int r=0;r<16;++r)negm[r]=-mhat; asm volatile("":"+v"(negm));
  qkt(pA0,pA1,Kbase,qr,negm,r32,hi);asm volatile("s_nop 15\n\ts_nop 7":"+v"(pA0),"+v"(pA1));CDEC(pA0,pA1,0);CMASK(pA0,pA1,0);
  START(pA0,pA1);
  _Pragma("unroll") for(int r=0;r<16;++r)pA1[r]=__builtin_amdgcn_exp2f(pA1[r]);
  WAIT_BAR(0);
  DMA_K(3,0);DMA_V(1,SLOTB);
  ROT();
  kload8(kf,kp0+sl_cur);
  WAIT_BAR(2);
  s16x4 vlo[8],vhi[8]; u32x4 pw0,pw1,pw2,pw3;
  #define PKW(P,B) cvtpk_s(P[B],P[B+1])
  #define PAF(k) __builtin_bit_cast(bf16x8,pw##k)
  #define VFR(i) (bf16x8){vlo[i][0],vlo[i][1],vlo[i][2],vlo[i][3],vhi[i][0],vhi[i][1],vhi[i][2],vhi[i][3]}
  #define PIN(x) asm volatile("":"+v"(x))
  #define MX3(a,b,c) __builtin_fmaxf(__builtin_fmaxf((a),(b)),(c))
  #define GAPA(MF,A0,A1,A2,A3,W0,W1,PW) do{ MF; sacc+=A0; sacc+=A1; sacc+=A2; sacc+=A3; PIN(sacc); W0; W1; PIN(PW); SBAR(); }while(0)
  #define EX(v) __builtin_amdgcn_exp2f(v)
  #define GAPB(MF,X,B) do{ MF; X[B]=EX(X[B]); X[B+1]=EX(X[B+1]); X[B+2]=EX(X[B+2]); X[B+3]=EX(X[B+3]); PIN(X); SBAR(); }while(0)
  #define VRD(i) do{ vlo[i]=vtr(vp_+(((i)>>2)*4096+((i)&3)*1024)); vhi[i]=vtr(vp_+(((i)>>2)*4096+((i)&3)*1024+512)); }while(0)
  #define KRD(G,j) do{ if(G){ kload2(kf,kp0+sl_next,j); SBAR(); } }while(0)
  #define STEP(C0,C1,P0,P1,t,GK,GV,GL) do{ SBAR(); \
    const lds_cptr vp_=vp0+sl_prev; \
    VRD(0); SBAR(); float sacc=(P0[0]+P0[1]); \
    GAPA(C0=__builtin_amdgcn_mfma_f32_32x32x16_bf16(kf[0],qr[0],negm,0,0,0), P0[2],P0[3],P0[4],P0[5],     pw0[0]=PKW(P0,0), pw0[1]=PKW(P0,2), pw0); \
    VRD(4); SBAR(); GAPA(C1=__builtin_amdgcn_mfma_f32_32x32x16_bf16(kf[1],qr[0],negm,0,0,0), P0[6],P0[7],P0[8],P0[9],     pw0[2]=PKW(P0,4), pw0[3]=PKW(P0,6), pw0); \
    VRD(1); SBAR(); GAPA(C0=__builtin_amdgcn_mfma_f32_32x32x16_bf16(kf[2],qr[1],C0,0,0,0),   P0[10],P0[11],P0[12],P0[13], pw1[0]=PKW(P0,8), pw1[1]=PKW(P0,10), pw1); \
    VRD(5); SBAR(); GAPA(C1=__builtin_amdgcn_mfma_f32_32x32x16_bf16(kf[3],qr[1],C1,0,0,0),   P0[14],P0[15],P1[0],P1[1],   pw1[2]=PKW(P0,12),pw1[3]=PKW(P0,14), pw1); \
    VRD(2); SBAR(); GAPA(C0=__builtin_amdgcn_mfma_f32_32x32x16_bf16(kf[4],qr[2],C0,0,0,0),   P1[2],P1[3],P1[4],P1[5],     pw2[0]=PKW(P1,0), pw2[1]=PKW(P1,2), pw2); \
    VRD(6); SBAR(); GAPA(C1=__builtin_amdgcn_mfma_f32_32x32x16_bf16(kf[5],qr[2],C1,0,0,0),   P1[6],P1[7],P1[8],P1[9],     pw2[2]=PKW(P1,4), pw2[3]=PKW(P1,6), pw2); \
    VRD(3); SBAR(); GAPA(C0=__builtin_amdgcn_mfma_f32_32x32x16_bf16(kf[6],qr[3],C0,0,0,0),   P1[10],P1[11],P1[12],P1[13], pw3[0]=PKW(P1,8), pw3[1]=PKW(P1,10), pw3); \
    VRD(7); SBAR(); GAPA(C1=__builtin_amdgcn_mfma_f32_32x32x16_bf16(kf[7],qr[3],C1,0,0,0),   P1[14],P1[15],0.f,0.f,       pw3[2]=PKW(P1,12),pw3[3]=PKW(P1,14), pw3); \
    l_reg+=sacc; \
    if(GK){DMA_K((t)+3,sl_cur);} if(GV){DMA_V((t)+1,sl_next);} \
    CDEC(C0,C1,t); CMASK(C0,C1,t); \
    { float a=MX3(C0[0],C0[1],C1[0]),b=MX3(C0[2],C0[3],C1[1]); a=MX3(a,C1[2],C1[3]); \
      _Pragma("unroll") for(int r=4;r<16;r+=4){a=MX3(a,C0[r],C0[r+1]);b=MX3(b,C0[r+2],C0[r+3]);a=MX3(a,C1[r],C1[r+1]);b=MX3(b,C1[r+2],C1[r+3]);} \
      float rm=__builtin_fmaxf(a,b); { auto rr=__builtin_amdgcn_permlane32_swap(__float_as_uint(rm),__float_as_uint(rm),false,false); rm=__builtin_fmaxf(__uint_as_float(rr[0]),__uint_as_float(rr[1])); } \
      resc=false; \
      if(__builtin_expect(__any(rm>(float)THRL),0)){ const float dl=__builtin_fmaxf(rm,0.f); mhat+=dl; \
        _Pragma("unroll") for(int r=0;r<16;++r){C0[r]-=dl;C1[r]-=dl;} \
        _Pragma("unroll") for(int r=0;r<16;++r)negm[r]=-mhat; asm volatile("":"+v"(negm)); \
        const float f=__builtin_amdgcn_exp2f(-dl); l_reg*=f; if(hi==0)wsf[r32]=f; resc=true; } } \
    SBAR(); \
    GAPB(o[0]=__builtin_amdgcn_mfma_f32_32x32x16_bf16(PAF(0),VFR(0),o[0],0,0,0), C0,0); \
    GAPB(o[1]=__builtin_amdgcn_mfma_f32_32x32x16_bf16(PAF(0),VFR(4),o[1],0,0,0), C0,4); \
    KRD(GL,0); GAPB(o[0]=__builtin_amdgcn_mfma_f32_32x32x16_bf16(PAF(1),VFR(1),o[0],0,0,0), C0,8); \
    KRD(GL,1); GAPB(o[1]=__builtin_amdgcn_mfma_f32_32x32x16_bf16(PAF(1),VFR(5),o[1],0,0,0), C0,12); \
    KRD(GL,2); GAPB(o[0]=__builtin_amdgcn_mfma_f32_32x32x16_bf16(PAF(2),VFR(2),o[0],0,0,0), C1,0); \
    KRD(GL,3); GAPB(o[1]=__builtin_amdgcn_mfma_f32_32x32x16_bf16(PAF(2),VFR(6),o[1],0,0,0), C1,4); \
    GAPB(o[0]=__builtin_amdgcn_mfma_f32_32x32x16_bf16(PAF(3),VFR(3),o[0],0,0,0), C1,8); \
    GAPB(o[1]=__builtin_amdgcn_mfma_f32_32x32x16_bf16(PAF(3),VFR(7),o[1],0,0,0), C1,12); \
    }while(0)
  int t=1;
  for(;t+5<NTE;t+=2){
    STEP(pB0,pB1,pA0,pA1,t,true,true,true);     WAIT_BAR(2); RESC(); ROT();
    STEP(pA0,pA1,pB0,pB1,t+1,true,true,true);   WAIT_BAR(2); RESC(); ROT();
  }
  #define ENDW(tt) do{ if((tt)+3<NTE){WAIT_BAR(2);} else if((tt)+2<NTE){WAIT_BAR(1);} else {WAIT_BAR(0);} }while(0)
  for(;t+1<NTE;t+=2){
    STEP(pB0,pB1,pA0,pA1,t,(t+3<NTE),(t+1<NTE),(t+1<NTE));       ENDW(t);   RESC(); ROT();
    STEP(pA0,pA1,pB0,pB1,t+1,(t+4<NTE),(t+2<NTE),(t+2<NTE));     ENDW(t+1); RESC(); ROT();
  }
  STEP(pB0,pB1,pA0,pA1,NTE-1,false,false,false); RESC();
  { float sacc=pB0[0]+pB0[1]; _Pragma("unroll") for(int r=2;r<16;++r)sacc+=pB0[r]; _Pragma("unroll") for(int r=0;r<16;++r)sacc+=pB1[r]; l_reg+=sacc;
    pw0=(u32x4){PKW(pB0,0),PKW(pB0,2),PKW(pB0,4),PKW(pB0,6)};pw1=(u32x4){PKW(pB0,8),PKW(pB0,10),PKW(pB0,12),PKW(pB0,14)};pw2=(u32x4){PKW(pB1,0),PKW(pB1,2),PKW(pB1,4),PKW(pB1,6)};pw3=(u32x4){PKW(pB1,8),PKW(pB1,10),PKW(pB1,12),PKW(pB1,14)};
    SBAR(); pv(o,vb0+sl_cur,PAF(0),PAF(1),PAF(2),PAF(3)); }
  #undef PKW
  #undef PAF
  #undef VFR
  #undef PIN
  #undef MX3
  #undef GAPA
  #undef GAPB
  #undef EX
  #undef VRD
  #undef KRD
  #undef STEP
  #undef ENDW
  {auto rr=__builtin_amdgcn_permlane32_swap(__float_as_uint(l_reg),__float_as_uint(l_reg),false,false);l_reg=__uint_as_float(rr[0])+__uint_as_float(rr[1]);}
  if(hi==0)wsf[32+r32]=l_reg;asm volatile("s_waitcnt lgkmcnt(0)":::"memory");
  float rli[16];
  #pragma unroll
  for(int r=0;r<16;++r)rli[r]=__builtin_amdgcn_rcpf(wsf[32+crow(r,hi)]);
  bf16*Ow=O+(rowbase+q0+wid*QBLK)*DM+h*D;
  { bf16*stg=(bf16*)(shm+LDS_OST)+wid*2048;
    #pragma unroll
    for(int r=0;r<16;++r){const int orow=crow(r,hi);
      #pragma unroll
      for(int d0=0;d0<2;++d0)stg[orow*64+d0*32+r32]=__float2bfloat16(o[d0][r]*rli[r]);}
    asm volatile("s_waitcnt lgkmcnt(0)":::"memory");
    const bf16*Zw=Zg+(rowbase+q0+wid*QBLK)*DM+h*D;
    #pragma unroll
    for(int i=0;i<4;++i){const int row=i*8+(lane>>3),ch=lane&7; const u32x4 v=*(const u32x4*)(stg+row*64+ch*8); const u32x4 zz=*(const u32x4*)(Zw+(long)row*DM+ch*8); u32x4 w;
      w.x=gate2(v.x,zz.x);w.y=gate2(v.y,zz.y);w.z=gate2(v.z,zz.z);w.w=gate2(v.w,zz.w); ATTN_STORE16(Ow+(long)row*DM+ch*8,w);} }
  asm volatile("s_waitcnt lgkmcnt(0)\n\ts_barrier":::"memory");
  #undef TILE
  #undef DMA_K
  #undef DMA_V
  #undef CMASK
  #undef CDEC
  #undef START
  #undef RESC
  #undef ROT
}
constexpr int ATTN_LDS_BYTES=LDS_BYTES;
struct AttnTensors { const bf16* Q; const bf16* K; const bf16* V; bf16* O; const bf16* Z; const float* C; const unsigned* NM; };
struct AttnUnit { int bh; int qb; };
struct StaticOrder {
  int vcu;
  __device__ __forceinline__ explicit StaticOrder(int grid,int block):vcu((block%8)*(grid/8)+block/8){}
  __device__ __forceinline__ bool next(int i,AttnUnit&u)const{ if(i>=4)return false; const int s=vcu&7; u.bh=vcu>>3; u.qb=(i==0)?s:(i==1)?15-s:(i==2)?16+s:31-s; return true; }
  __device__ __forceinline__ void a_ready(const AttnUnit&)const{}
  __device__ __forceinline__ void done(const AttnUnit&)const{}
};
template<class Sched,int THRL=8> __device__ __forceinline__ void attn_phase(char*lds,const AttnTensors&T,const Sched&S,const int wave_id){
  AttnUnit u;
  for(int i=0;S.next(i,u);++i){ S.a_ready(u); attn_unit<THRL>(u.bh/NHEAD,u.bh%NHEAD,u.qb,T.Q,T.K,T.V,T.O,T.Z,T.C,T.NM,lds,wave_id); S.done(u); }
}
#undef SBAR
#undef WAIT_BAR
}

#define GAS __attribute__((address_space(1)))
#define LAS __attribute__((address_space(3)))
typedef unsigned short bf16;
typedef unsigned v4u __attribute__((ext_vector_type(4)));
typedef float f32x4 __attribute__((ext_vector_type(4)));
typedef short bf16x8 __attribute__((ext_vector_type(8)));
typedef GAS unsigned gu32;
typedef GAS unsigned long long gu64;
#define RLX_AGENT __ATOMIC_RELAXED, __HIP_MEMORY_SCOPE_AGENT
#define LDS_WAIT() asm volatile("s_waitcnt lgkmcnt(0)" ::: "memory")
#define VM_WAIT() asm volatile("s_waitcnt vmcnt(0)" ::: "memory")
__device__ __forceinline__ unsigned long long rt() { return __builtin_amdgcn_s_memrealtime(); }
__device__ __forceinline__ unsigned f2bf(float f) { unsigned u = __builtin_bit_cast(unsigned, f); return (u + 0x7fffu + ((u >> 16) & 1u)) >> 16; }
__device__ __forceinline__ unsigned pk2(float lo, float hi) { return f2bf(lo) | (f2bf(hi) << 16); }

#define XB_TMO      128
#define XB_XCNT(j)  (256  + 64 * (j))
#define XB_XSUB(j)  (1280 + 64 * (j))
#define XB_XGEN(j)  (2304 + 64 * (j))
#define XB_TOP      3328
#define XB_TOPGEN   3392
#define XCD_BAR_WORDS 3456
#define XB_SPIN_CAP (1u << 18)

__device__ __forceinline__ unsigned xb_ld(unsigned* p)              { return __hip_atomic_load(p, __ATOMIC_RELAXED, __HIP_MEMORY_SCOPE_AGENT); }
__device__ __forceinline__ unsigned xb_add(unsigned* p, unsigned v) { return __hip_atomic_fetch_add(p, v, __ATOMIC_RELAXED, __HIP_MEMORY_SCOPE_AGENT); }
__device__ __forceinline__ unsigned xb_xcc_id() { return (unsigned)__builtin_amdgcn_s_getreg((3 << 11) | 20) & 0xFu; }
#define XB_SPIN(cond, bar) do { unsigned _sp = 0; while (cond) { __builtin_amdgcn_s_sleep(1); \
    if ((++_sp & 255u) == 0u) { if (xb_ld(&(bar)[XB_TMO])) break; if (_sp > XB_SPIN_CAP) { atomicAdd(&(bar)[XB_TMO], 1u); break; } } } } while (0)

struct XcdBarrier {
    unsigned* bar; unsigned x; int wave;
    volatile LAS unsigned* st;
};

__device__ __forceinline__ XcdBarrier xcd_barrier_post(unsigned* bar, volatile LAS unsigned* st, int wave) {
    XcdBarrier b; b.bar = bar; b.x = xb_xcc_id(); b.st = st; b.wave = wave;
    if (wave == 0 && lane_id_() == 0) (void)xb_add(&bar[XB_XCNT(b.x)], 1u);
    return b;
}
__device__ __forceinline__ void xcd_barrier_complete(unsigned* bar, unsigned x, unsigned& nloc, unsigned& nx) {
    const unsigned G = gridDim.x * gridDim.y * gridDim.z;
    unsigned sum, cnt, mine, sp = 0u;
    for (;;) {
        sum = 0u; cnt = 0u; mine = 0u;
#pragma unroll
        for (unsigned j = 0; j < 16; ++j) { const unsigned c = xb_ld(&bar[XB_XCNT(j)]); sum += c; cnt += (c > 0u) ? 1u : 0u; mine = (j == x) ? c : mine; }
        if (sum == G) break;
        __builtin_amdgcn_s_sleep(1);
        if ((++sp & 255u) == 0u) { if (xb_ld(&bar[XB_TMO])) break; if (sp > XB_SPIN_CAP) { atomicAdd(&bar[XB_TMO], 1u); break; } }
    }
    nloc = mine > 0u ? mine : 1u; nx = cnt > 0u ? cnt : 1u;
}

__device__ __forceinline__ void xcd_barrier(const XcdBarrier& b) {
    asm volatile("s_waitcnt vmcnt(0)" ::: "memory");
    __syncthreads();
    if (b.wave == 0 && lane_id_() == 0) {
        unsigned* bar = b.bar;
        __builtin_amdgcn_s_waitcnt(0);
        unsigned nloc = b.st[0], nx = b.st[1];
        if (nloc == 0u) { xcd_barrier_complete(bar, b.x, nloc, nx); b.st[0] = nloc; b.st[1] = nx; }
        const unsigned old = xb_add(&bar[XB_XSUB(b.x)], 1u);
        const unsigned gen = old / nloc;
        if (old + 1u == (gen + 1u) * nloc) {
            __builtin_amdgcn_fence(__ATOMIC_RELEASE, "agent");
            asm volatile("s_waitcnt vmcnt(0)" ::: "memory");
            const unsigned og = xb_add(&bar[XB_TOP], 1u);
            const unsigned tg = og / nx;
            if (og + 1u == (tg + 1u) * nx) xb_add(&bar[XB_TOPGEN], 1u);
            else XB_SPIN(xb_ld(&bar[XB_TOPGEN]) == tg, bar);
            __builtin_amdgcn_fence(__ATOMIC_ACQUIRE, "agent");
            xb_add(&bar[XB_XGEN(b.x)], 1u);
            asm volatile("s_waitcnt vmcnt(0)" ::: "memory");
        } else {
            XB_SPIN(xb_ld(&bar[XB_XGEN(b.x)]) == gen, bar);
            __builtin_amdgcn_fence(__ATOMIC_ACQUIRE, "agent");
            asm volatile("s_waitcnt vmcnt(0)" ::: "memory");
        }
    }
    __syncthreads();
}

namespace dil {
using attn_body::bf16x8; using attn_body::s16x4; using attn_body::f32x16; using attn_body::u32x4; using attn_body::lds_cptr; using attn_body::vtr; using attn_body::cvtpk_s; using attn_body::crow;
constexpr int KS = 272, VS = 320, KBYTES = 64 * KS, VBYTES = 64 * VS, UNIT_LDS = KBYTES + VBYTES;
constexpr int WSF_OFF = 2 * UNIT_LDS, DIL_LDS_BYTES = WSF_OFF + 8 * 256;
constexpr int LDQ = 3072;
typedef __attribute__((address_space(3))) char* lds_ptr;
typedef __attribute__((address_space(3))) float* lds_fp;

__device__ __forceinline__ void dil_phase(char* lds_g, unsigned short* Qb, const unsigned short* __restrict__ Kb, const unsigned short* __restrict__ Vb, float* lse, int grid, int block, const int wave_id) {
    int tid_ = wave_id * 64 + lane_id_(); asm volatile("" : "+v"(tid_)); const int tid = tid_, lane = tid & 63, r32 = lane & 31, hi = lane >> 5; const int wid = __builtin_amdgcn_readfirstlane(tid >> 6);
    const int half = wid >> 2, w4 = wid & 3, tu = tid & 255;
    const lds_ptr lds = (lds_ptr)lds_g;
    const lds_ptr Kl = lds + half * UNIT_LDS, Vl = Kl + KBYTES;
    const lds_fp wsf = (lds_fp)(lds + WSF_OFF) + wid * 64;
    for (int up = block; up < 768; up += grid) {
        const int u = 2 * up + half;
        const int g = u >> 9, rem = u & 511, h = rem & 7, pb = rem >> 3, dsh = 2 * g;
        const int nbm = (64 >> dsh) - 1, n = pb & nbm, r = pb >> (6 - dsh);
        const int colq = g * 1024 + h * 128;
        const int i_q = 32 * w4 + r32;
        const long tq = ((long)(128 * n + i_q) << dsh) + r;
        bf16x8 qr[8];
#pragma unroll
        for (int d0 = 0; d0 < 8; ++d0) qr[d0] = *(const bf16x8*)(Qb + tq * LDQ + colq + d0 * 16 + hi * 8);
        const float slope2 = __builtin_amdgcn_exp2f(-(float)(g * 8 + h + 1) * (8.0f / 24.0f)) * 1.4426950408889634f * (float)(1 << dsh);
        float mrun = -1e30f, l_reg = 0.f; f32x16 o[4];
#pragma unroll
        for (int d0 = 0; d0 < 4; ++d0) o[d0] = f32x16{};
        u32x4 kreg[4], vreg[4];
#define DIL_LOAD(kt) do { _Pragma("unroll") for (int i_ = 0; i_ < 4; ++i_) { const int p_ = tu + 256 * i_, row_ = p_ >> 4, ch_ = p_ & 15; \
            int lk_ = 128 * (n - 1) + 64 * (kt) + row_; lk_ = lk_ < 0 ? 0 : lk_; const long tk_ = ((long)lk_ << dsh) + r; \
            kreg[i_] = *(const u32x4*)(Kb + tk_ * LDQ + colq + ch_ * 8); vreg[i_] = *(const u32x4*)(Vb + tk_ * LDQ + colq + ch_ * 8); } } while (0)
        DIL_LOAD(0);
        const lds_cptr kb = (lds_cptr)Kl + r32 * KS + hi * 16;
        const lds_cptr vb = (lds_cptr)Vl + (4 * hi + ((lane & 15) >> 2)) * VS + ((lane >> 4) & 1) * 32 + (lane & 3) * 8;
#pragma unroll 1
        for (int kt = 0; kt < 4; ++kt) {
            __syncthreads();
#pragma unroll
            for (int i_ = 0; i_ < 4; ++i_) { const int p_ = tu + 256 * i_, row_ = p_ >> 4, ch_ = p_ & 15;
                *(__attribute__((address_space(3))) u32x4*)(Kl + row_ * KS + ch_ * 16) = kreg[i_]; *(__attribute__((address_space(3))) u32x4*)(Vl + row_ * VS + ch_ * 16) = vreg[i_]; }
            __syncthreads();
            if (kt < 3) DIL_LOAD(kt + 1);
            const bool active = (kt >= (w4 >> 1)) && (kt <= (w4 >> 1) + 2) && !(n == 0 && kt < 2);
            if (active) {
                f32x16 p0 = f32x16{}, p1 = f32x16{};
#pragma unroll
                for (int d0 = 0; d0 < 8; ++d0) {
                    const bf16x8 b0 = *(const __attribute__((address_space(3))) bf16x8*)(kb + d0 * 32);
                    const bf16x8 b1 = *(const __attribute__((address_space(3))) bf16x8*)(kb + 32 * KS + d0 * 32);
                    p0 = __builtin_amdgcn_mfma_f32_32x32x16_bf16(b0, qr[d0], p0, 0, 0, 0);
                    p1 = __builtin_amdgcn_mfma_f32_32x32x16_bf16(b1, qr[d0], p1, 0, 0, 0);
                }
                const int dbase = 128 + i_q - 64 * kt - 4 * hi; const bool nz = n > 0; const int jb = 64 * kt + 4 * hi;
                float rm = -INFINITY;
#pragma unroll
                for (int rr = 0; rr < 16; ++rr) { const int cr = (rr & 3) + 8 * (rr >> 2); const int d0_ = dbase - cr, d1_ = d0_ - 32;
                    const bool v0 = ((unsigned)d0_ <= 128u) && (nz || (jb + cr) >= 128), v1 = ((unsigned)d1_ <= 128u) && (nz || (jb + cr + 32) >= 128);
                    p0[rr] = v0 ? p0[rr] - slope2 * (float)d0_ : -INFINITY; p1[rr] = v1 ? p1[rr] - slope2 * (float)d1_ : -INFINITY;
                    rm = fmaxf(rm, fmaxf(p0[rr], p1[rr])); }
                { auto sw_ = __builtin_amdgcn_permlane32_swap(__float_as_uint(rm), __float_as_uint(rm), false, false); rm = fmaxf(__uint_as_float(sw_[0]), __uint_as_float(sw_[1])); }
                const float mnew = fmaxf(mrun, rm), alpha = __builtin_amdgcn_exp2f(mrun - mnew); mrun = mnew;
                float rs = 0.f;
#pragma unroll
                for (int rr = 0; rr < 16; ++rr) { p0[rr] = __builtin_amdgcn_exp2f(p0[rr] - mnew); p1[rr] = __builtin_amdgcn_exp2f(p1[rr] - mnew); rs += p0[rr] + p1[rr]; }
                l_reg = l_reg * alpha + rs;
                if (hi == 0) wsf[r32] = alpha;
                bf16x8 pa[4];
                { u32x4 w0, w1, w2, w3;
                  w0.x = cvtpk_s(p0[0], p0[1]); w0.y = cvtpk_s(p0[2], p0[3]); w0.z = cvtpk_s(p0[4], p0[5]); w0.w = cvtpk_s(p0[6], p0[7]);
                  w1.x = cvtpk_s(p0[8], p0[9]); w1.y = cvtpk_s(p0[10], p0[11]); w1.z = cvtpk_s(p0[12], p0[13]); w1.w = cvtpk_s(p0[14], p0[15]);
                  w2.x = cvtpk_s(p1[0], p1[1]); w2.y = cvtpk_s(p1[2], p1[3]); w2.z = cvtpk_s(p1[4], p1[5]); w2.w = cvtpk_s(p1[6], p1[7]);
                  w3.x = cvtpk_s(p1[8], p1[9]); w3.y = cvtpk_s(p1[10], p1[11]); w3.z = cvtpk_s(p1[12], p1[13]); w3.w = cvtpk_s(p1[14], p1[15]);
                  pa[0] = __builtin_bit_cast(bf16x8, w0); pa[1] = __builtin_bit_cast(bf16x8, w1); pa[2] = __builtin_bit_cast(bf16x8, w2); pa[3] = __builtin_bit_cast(bf16x8, w3); }
                { float al[16];
#pragma unroll
                  for (int rr = 0; rr < 16; ++rr) al[rr] = wsf[crow(rr, hi)];
#pragma unroll
                  for (int d0 = 0; d0 < 4; ++d0)
#pragma unroll
                      for (int rr = 0; rr < 16; ++rr) o[d0][rr] *= al[rr]; }
#pragma unroll
                for (int d0 = 0; d0 < 4; ++d0)
#pragma unroll
                    for (int ks = 0; ks < 4; ++ks) {
                        const s16x4 lo = vtr(vb + ks * 16 * VS + d0 * 64), hh = vtr(vb + ks * 16 * VS + 8 * VS + d0 * 64);
                        const bf16x8 vf = (bf16x8){lo[0], lo[1], lo[2], lo[3], hh[0], hh[1], hh[2], hh[3]};
                        o[d0] = __builtin_amdgcn_mfma_f32_32x32x16_bf16(pa[ks], vf, o[d0], 0, 0, 0);
                    }
            }
        }
#undef DIL_LOAD
        float ltot; { auto sw_ = __builtin_amdgcn_permlane32_swap(__float_as_uint(l_reg), __float_as_uint(l_reg), false, false); ltot = __uint_as_float(sw_[0]) + __uint_as_float(sw_[1]); }
        if (hi == 0) { wsf[32 + r32] = __builtin_amdgcn_rcpf(ltot); lse[((size_t)g * 8192 + tq) * 8 + h] = mrun + log2f(ltot); }
        __syncthreads();
        { const lds_ptr stg = Kl + w4 * 8192;
          float rl[16];
#pragma unroll
          for (int rr = 0; rr < 16; ++rr) rl[rr] = wsf[32 + crow(rr, hi)];
#pragma unroll
          for (int rr = 0; rr < 16; ++rr) { const int orow = crow(rr, hi);
#pragma unroll
              for (int d0 = 0; d0 < 4; ++d0) { const unsigned pk = cvtpk_s(o[d0][rr] * rl[rr], 0.f); *(__attribute__((address_space(3))) unsigned short*)(stg + orow * 256 + (d0 * 32 + r32) * 2) = (unsigned short)pk; } }
#pragma unroll
          for (int i_ = 0; i_ < 8; ++i_) { const int row = i_ * 4 + (lane >> 4), ch = lane & 15;
              const u32x4 v = *(const __attribute__((address_space(3))) u32x4*)(stg + row * 256 + ch * 16);
              const long tr = ((long)(128 * n + 32 * w4 + row) << dsh) + r;
              *(u32x4*)(Qb + tr * LDQ + colq + ch * 8) = v; } }
    }
    __syncthreads();
}
}

namespace cg = cooperative_groups;
constexpr int NWAVES = 8;
constexpr int BATCH = 2, SEQ = 8192, D = 1024, M = BATCH * SEQ, FOX_IN = 4112, DIL_IN = 10240, PLE = 256;
constexpr float RMS_EPS = 1e-6f, LOG2E = 1.4426950408889634f;
constexpr float C2D = 0.08838834764831845f * LOG2E;

constexpr size_t MiB = 1u << 20, KiB = 1024;
constexpr size_t WS_CTL = 0, CTL_ZERO_BYTES = 1 * MiB;
constexpr size_t WS_SS = 1 * MiB;
constexpr size_t WS_C = 2 * MiB;
constexpr size_t WS_LSE = 3 * MiB;
constexpr size_t WS_WFIN = 4 * MiB, WS_WFOUT = 12 * MiB, WS_WUP0 = 14 * MiB, WS_WG0 = 14 * MiB + 512 * KiB, WS_PB0 = 16 * MiB + 512 * KiB;
constexpr size_t WS_A1 = 24 * MiB + 512 * KiB;
constexpr size_t WS_PB1 = 56 * MiB + 512 * KiB, WS_WUP1 = 64 * MiB + 512 * KiB, WS_WG1 = 65 * MiB, WS_WDOUT = 67 * MiB, WS_WDIN = 69 * MiB;
constexpr size_t WS_Q = 89 * MiB, WS_K = 121 * MiB, WS_V = 153 * MiB, WS_Z = 185 * MiB;
constexpr size_t WS_Q1 = 89 * MiB, WS_K1 = 137 * MiB, WS_V1 = 185 * MiB, WS_Z1 = 233 * MiB;
constexpr size_t WS_A2 = 4 * MiB;
constexpr size_t WS_H3B = 89 * MiB, WS_U1 = 121 * MiB;
constexpr size_t WS_END = 256 * MiB;
static_assert(WS_WDIN + (size_t)DIL_IN * D * 2 <= WS_Q && WS_Z1 + (size_t)SEQ * D * 2 <= WS_END && WS_A2 + (size_t)M * D * 2 <= WS_A1 + (size_t)SEQ * D * 2, "d_ws map");
constexpr int CW_BAR = 4096, CW_NM = 8192;

constexpr int RING_OFF = 0, RING_BYTES = 131072;
constexpr int LDS_BYTES = 147456, LDSCTL_OFF = LDS_BYTES - 512, MISC_OFF = LDSCTL_OFF + 320;
static_assert(attn_body::LDS_BYTES <= RING_BYTES && dil::DIL_LDS_BYTES <= RING_BYTES, "LDS map");

struct Args { const float* in[12]; float* out; unsigned char* ws; };

__device__ __forceinline__ void p0_transpose_item(const float* W, int K, int ldw, int nblk, bf16* WT, LAS float* scr, int item, int lane) {
    const int kb = item / nblk, nb = item % nblk, k0 = 64 * kb, n0 = 32 * nb;
#pragma unroll 8
    for (int i = 0; i < 32; ++i) { const int kk = 2 * i + (lane >> 5); scr[kk * 33 + (lane & 31)] = W[(size_t)(k0 + kk) * ldw + n0 + (lane & 31)]; }
    LDS_WAIT(); asm volatile("" ::: "memory");
    const int c = lane & 7;
#pragma unroll
    for (int j = 0; j < 4; ++j) { const int n = (lane >> 3) + 8 * j; const LAS float* s = scr + (8 * c) * 33 + n;
        v4u o; o.x = pk2(s[0 * 33], s[1 * 33]); o.y = pk2(s[2 * 33], s[3 * 33]); o.z = pk2(s[4 * 33], s[5 * 33]); o.w = pk2(s[6 * 33], s[7 * 33]);
        *(GAS v4u*)(WT + (size_t)(n0 + n) * K + k0 + 8 * c) = o; }
    LDS_WAIT(); asm volatile("" ::: "memory");
}

__global__ void __launch_bounds__(NWAVES * 64, 2) trunk_fwd(Args args) {
    extern __shared__ __attribute__((aligned(16))) unsigned char lds[];
    LAS unsigned char* const ldsl = (LAS unsigned char*)lds;
    volatile LAS unsigned* const MISC = (volatile LAS unsigned*)(ldsl + MISC_OFF);
    const int wave = __builtin_amdgcn_readfirstlane((int)threadIdx.x >> 6);
#define FRESH_TID() int tid = wave * 64 + lane_id_(); asm volatile("" : "+v"(tid)); const int lane = tid & 63; (void)lane
    const int G = gridDim.x, bx = blockIdx.x, vcu = (G % 8 == 0) ? (bx % 8) * (G / 8) + bx / 8 : bx;
#define WSP (args.ws)
#define CTLP ((gu32*)(args.ws + WS_CTL))
#define IN_X (args.in[0])
#define IN_P (args.in[1])
#define IN_FNORM (args.in[2])
#define IN_FWIN (args.in[3])
#define IN_FBF (args.in[4])
#define IN_FWOUT (args.in[5])
#define IN_DNORM (args.in[6])
#define IN_DWIN (args.in[7])
#define IN_DWOUT (args.in[8])
#define IN_WUP (args.in[9])
#define IN_WGATE (args.in[10])
#define IN_FINORM (args.in[11])
#define HRES (args.out)
#define W_FIN ((bf16*)(args.ws + WS_WFIN))
#define W_FOUT ((bf16*)(args.ws + WS_WFOUT))
#define W_UP0 ((bf16*)(args.ws + WS_WUP0))
#define W_G0 ((bf16*)(args.ws + WS_WG0))
#define W_UP1 ((bf16*)(args.ws + WS_WUP1))
#define W_G1 ((bf16*)(args.ws + WS_WG1))
#define W_DOUT ((bf16*)(args.ws + WS_WDOUT))
#define W_DIN ((bf16*)(args.ws + WS_WDIN))
#define PB0 ((bf16*)(args.ws + WS_PB0))
#define PB1 ((bf16*)(args.ws + WS_PB1))
#define A1 ((bf16*)(args.ws + WS_A1))
#define A2 ((bf16*)(args.ws + WS_A2))
#define QB ((bf16*)(args.ws + WS_Q))
#define KB ((bf16*)(args.ws + WS_K))
#define VB ((bf16*)(args.ws + WS_V))
#define ZB ((bf16*)(args.ws + WS_Z))
#define Q1 ((bf16*)(args.ws + WS_Q1))
#define K1 ((bf16*)(args.ws + WS_K1))
#define V1 ((bf16*)(args.ws + WS_V1))
#define Z1 ((bf16*)(args.ws + WS_Z1))
#define SS ((float*)(args.ws + WS_SS))
#define CC ((float*)(args.ws + WS_C))
#define LSE ((float*)(args.ws + WS_LSE))
    for (int u = (int)threadIdx.x; u < (LDS_BYTES - LDSCTL_OFF) / 4; u += NWAVES * 64) ((LAS unsigned*)(ldsl + LDSCTL_OFF))[u] = 0u;
    __syncthreads();
    XcdBarrier bar = xcd_barrier_post((unsigned*)(CTLP + CW_BAR), MISC + 8, wave);
    const int gw = vcu * NWAVES + wave, NGW = G * NWAVES;

    {
        FRESH_TID();
        LAS float* scr = (LAS float*)(ldsl + wave * 16384);
        constexpr int I_FIN = 16 * 128, I_SQ = 16 * 32, I_DIN = 16 * 320, I_UP = 4 * 32;
        constexpr int NITEMS = I_FIN + 4 * I_SQ + I_DIN + 2 * I_UP;
        for (int it = gw; it < NITEMS; it += NGW) {
            int r = it;
            if (r < I_DIN) { p0_transpose_item(IN_DWIN, D, DIL_IN, 320, W_DIN, scr, r, lane); continue; } r -= I_DIN;
            if (r < I_FIN) { p0_transpose_item(IN_FWIN, D, FOX_IN, 128, W_FIN, scr, r, lane); continue; } r -= I_FIN;
            if (r < I_SQ) { p0_transpose_item(IN_FWOUT, D, D, 32, W_FOUT, scr, r, lane); continue; } r -= I_SQ;
            if (r < I_SQ) { p0_transpose_item(IN_DWOUT, D, D, 32, W_DOUT, scr, r, lane); continue; } r -= I_SQ;
            if (r < I_SQ) { p0_transpose_item(IN_WGATE, D, D, 32, W_G0, scr, r, lane); continue; } r -= I_SQ;
            if (r < I_SQ) { p0_transpose_item(IN_WGATE + (size_t)D * D, D, D, 32, W_G1, scr, r, lane); continue; } r -= I_SQ;
            if (r < I_UP) { p0_transpose_item(IN_WUP, PLE, D, 32, W_UP0, scr, r, lane); continue; } r -= I_UP;
            p0_transpose_item(IN_WUP + (size_t)PLE * D, PLE, D, 32, W_UP1, scr, r, lane);
        }
        { const size_t n8 = (size_t)2 * M * PLE / 8, half8 = (size_t)M * PLE / 8;
          for (size_t i = (size_t)gw * 64 + lane; i < n8; i += (size_t)NGW * 64) {
              const f32x4 a = *(const GAS f32x4*)(IN_P + i * 8), b = *(const GAS f32x4*)(IN_P + i * 8 + 4);
              v4u o; o.x = pk2(a[0], a[1]); o.y = pk2(a[2], a[3]); o.z = pk2(b[0], b[1]); o.w = pk2(b[2], b[3]);
              bf16* dst = i < half8 ? PB0 + i * 8 : PB1 + (i - half8) * 8; *(GAS v4u*)dst = o; } }
        __syncthreads();
        LAS float* wf = (LAS float*)ldsl;
        for (int idx = tid; idx < 16 * 1024; idx += NWAVES * 64) { const int k = idx >> 4, n = idx & 15; wf[n * 1024 + k] = IN_FWIN[(size_t)k * FOX_IN + 4096 + n]; }
        __syncthreads();
        f32x4 g4[4];
#pragma unroll
        for (int j = 0; j < 4; ++j) g4[j] = *(const GAS f32x4*)(IN_FNORM + 4 * lane + 256 * j);
        for (int m = 2 * gw; m < M; m += 2 * NGW) {
            f32x4 v[2][4]; float s2[2] = {0.f, 0.f};
#pragma unroll
            for (int rr = 0; rr < 2; ++rr)
#pragma unroll
                for (int j = 0; j < 4; ++j) { v[rr][j] = *(const GAS f32x4*)(IN_X + (size_t)(m + rr) * D + 4 * lane + 256 * j); s2[rr] += (v[rr][j].x * v[rr][j].x + v[rr][j].y * v[rr][j].y) + (v[rr][j].z * v[rr][j].z + v[rr][j].w * v[rr][j].w); }
#pragma unroll
            for (int rr = 0; rr < 2; ++rr) { const float rstd = 1.0f / sqrtf(wave_sum(s2[rr]) * (1.f / D) + RMS_EPS);
                GAS unsigned long long* o8 = (GAS unsigned long long*)(A1 + (size_t)(m + rr) * D) + lane;
#pragma unroll
                for (int j = 0; j < 4; ++j) { v[rr][j] = v[rr][j] * rstd * g4[j];
                    o8[64 * j] = (unsigned long long)pk2(v[rr][j].x, v[rr][j].y) | ((unsigned long long)pk2(v[rr][j].z, v[rr][j].w) << 32); } }
            float a0[16], a1[16];
#pragma unroll
            for (int n = 0; n < 16; ++n) { float t0 = 0.f, t1 = 0.f;
#pragma unroll
                for (int j = 0; j < 4; ++j) { const f32x4 w = *(const LAS f32x4*)(wf + n * 1024 + 256 * j + 4 * lane);
                    t0 += (v[0][j].x * w.x + v[0][j].y * w.y) + (v[0][j].z * w.z + v[0][j].w * w.w); t1 += (v[1][j].x * w.x + v[1][j].y * w.y) + (v[1][j].z * w.z + v[1][j].w * w.w); }
                a0[n] = t0; a1[n] = t1; if (n & 1) asm volatile("" ::: "memory"); }
#define TRED(a) do { \
            { const bool up_ = (lane & 32) != 0; _Pragma("unroll") for (int i = 0; i < 8; ++i) { const float snd = up_ ? a[i] : a[i + 8], kp = up_ ? a[i + 8] : a[i]; auto r_ = __builtin_amdgcn_permlane32_swap(__float_as_uint(snd), __float_as_uint(snd), false, false); a[i] = kp + __uint_as_float(up_ ? r_[0] : r_[1]); } } \
            { const bool up_ = (lane & 16) != 0; _Pragma("unroll") for (int i = 0; i < 4; ++i) { const float snd = up_ ? a[i] : a[i + 4], kp = up_ ? a[i + 4] : a[i]; a[i] = kp + shx<16>(snd); } } \
            { const bool up_ = (lane & 8) != 0; _Pragma("unroll") for (int i = 0; i < 2; ++i) { const float snd = up_ ? a[i] : a[i + 2], kp = up_ ? a[i + 2] : a[i]; a[i] = kp + shx<8>(snd); } } \
            { const bool up_ = (lane & 4) != 0; const float snd = up_ ? a[0] : a[1], kp = up_ ? a[1] : a[0]; a[0] = kp + shx<4>(snd); } \
            a[0] += shx<1>(a[0]); a[0] += shx<2>(a[0]); } while (0)
            TRED(a0); TRED(a1);
#undef TRED
            if ((lane & 3) == 0) { const int n = (lane >> 2) & 15; const float bf = IN_FBF[n];
#pragma unroll
                for (int rr = 0; rr < 2; ++rr) { const float fl = (rr ? a1[0] : a0[0]) + bf;
                    const float lf = fminf(fl, 0.f) - log1pf(expf(-fabsf(fl)));
                    const int mm = m + rr, b = mm / SEQ, s = mm % SEQ; CC[(size_t)(b * 16 + n) * SEQ + s] = lf; } }
        }
    }
    if (args.out == nullptr) cg::this_grid().sync();
    xcd_barrier(bar);

    if (bx < 32) {
        FRESH_TID();
        float* c = CC + (size_t)bx * SEQ + tid * 16; LAS float* wt = (LAS float*)(ldsl + LDSCTL_OFF);
        f32x4 v[4]; float run = 0.f;
#pragma unroll
        for (int j = 0; j < 4; ++j) { v[j] = *(const GAS f32x4*)(c + 4 * j); v[j].x += run; v[j].y += v[j].x; v[j].z += v[j].y; v[j].w += v[j].z; run = v[j].w; }
        LAS float* tt = (LAS float*)ldsl;
        tt[tid] = run;
        __syncthreads();
        float off = 0.f;
        for (int k = 0; k < lane; ++k) off += tt[wave * 64 + k];
        if (lane == 63) wt[wave] = off + run;
        __syncthreads();
        for (int w = 0; w < wave; ++w) off += wt[w];
#pragma unroll
        for (int j = 0; j < 4; ++j) { v[j] = (v[j] + off) * LOG2E; *(GAS f32x4*)(c + 4 * j) = v[j]; }
        __syncthreads();
    }
    {
        pg8::Gemm g{A1, W_FIN, M, 4096, D}; pg8::StaticOrder S; S.init(M, 4096, G, bx);
        pg8::EpiFoxIn E{QB, (size_t)(WS_K - WS_Q) / 2, attn_body::C2, (unsigned*)(CTLP + CW_NM)};
#ifndef NO_G1
        pg8::gemm_phase<pg8::EpiFoxIn, pg8::StaticOrder, true, true>(ldsl + RING_OFF, g, S, E, wave);
#endif
    }
    xcd_barrier(bar);

    {
        const attn_body::AttnTensors AT{(const attn_body::bf16*)QB, (const attn_body::bf16*)KB, (const attn_body::bf16*)VB, (attn_body::bf16*)QB, (const attn_body::bf16*)ZB, CC, (const unsigned*)(CTLP + CW_NM)};
        const attn_body::StaticOrder S(G, bx);
#ifndef NO_ATTN
        attn_body::attn_phase<attn_body::StaticOrder>((char*)lds + RING_OFF, AT, S, wave);
#endif

    }
    xcd_barrier(bar);

    {
        pg8::Gemm g{QB, W_FOUT, M, D, D}; pg8::StaticOrder S; S.init(M, D, G, bx);
        pg8::EpiResid E{IN_X, HRES, KB};
#ifndef NO_G2
        pg8::gemm_phase<pg8::EpiResid, pg8::StaticOrder, true, true>(ldsl + RING_OFF, g, S, E, wave);
#endif
        int kple = PLE; asm volatile("" : "+s"(kple));
        pg8::Gemm g2{PB0, W_UP0, M, D, kple}; pg8::StaticOrder S2; S2.init(M, D, G, bx);
        pg8::EpiBf16<0> E2{VB, D, nullptr, 0, 0, 1.f};
#ifndef NO_G3
        pg8::gemm_phase<pg8::EpiBf16<0>, pg8::StaticOrder, true, true>(ldsl + RING_OFF, g2, S2, E2, wave);
#endif
    }
    xcd_barrier(bar);

    {
        pg8::Gemm g{KB, W_G0, M, D, D}; pg8::StaticOrder S; S.init(M, D, G, bx);
        pg8::EpiGate E{HRES, VB, A1, IN_DNORM, SS};
#ifndef NO_G4
        pg8::gemm_phase<pg8::EpiGate, pg8::StaticOrder, true, true>(ldsl + RING_OFF, g, S, E, wave);
#endif
    }
    xcd_barrier(bar);

    for (int b = 0; b < BATCH; ++b) {
        {
            pg8::Gemm g{A1 + (size_t)b * SEQ * D, W_DIN, SEQ, DIL_IN, D}; pg8::StaticOrder S; S.init(SEQ, DIL_IN, G, bx);
            pg8::EpiIn1 E{Q1, K1, V1, Z1, SS + (size_t)b * SEQ * 16, C2D, RMS_EPS};
#ifndef NO_G5
            pg8::gemm_phase<pg8::EpiIn1, pg8::StaticOrder, true, true>(ldsl + RING_OFF, g, S, E, wave);
#endif
        }
        xcd_barrier(bar);
#ifndef NO_DIL
        dil::dil_phase((char*)lds + RING_OFF, Q1, K1, V1, LSE, G, bx, wave);
#endif

        xcd_barrier(bar);
        FRESH_TID();
        for (int t = gw; t < SEQ; t += NGW) {
#pragma unroll
            for (int part = 0; part < 2; ++part) { const int c = part * 512 + 8 * lane, h = c >> 7;
                const float l0 = LSE[((size_t)0 * SEQ + t) * 8 + h], l1 = LSE[((size_t)1 * SEQ + t) * 8 + h], l2 = LSE[((size_t)2 * SEQ + t) * 8 + h];
                const float mx = fmaxf(l0, fmaxf(l1, l2)); float w0 = __builtin_amdgcn_exp2f(l0 - mx), w1 = __builtin_amdgcn_exp2f(l1 - mx), w2 = __builtin_amdgcn_exp2f(l2 - mx);
                const float inv = 1.0f / (w0 + w1 + w2); w0 *= inv; w1 *= inv; w2 *= inv;
                const v4u o0 = *(const GAS v4u*)(Q1 + (size_t)t * 3072 + c), o1 = *(const GAS v4u*)(Q1 + (size_t)t * 3072 + 1024 + c), o2 = *(const GAS v4u*)(Q1 + (size_t)t * 3072 + 2048 + c);
                const v4u zz = *(const GAS v4u*)(Z1 + (size_t)t * D + c); v4u r;
#define MRG1(f) { const float e0 = w0 * pg8::bf_lo(o0.f) + w1 * pg8::bf_lo(o1.f) + w2 * pg8::bf_lo(o2.f), e1 = w0 * pg8::bf_hi(o0.f) + w1 * pg8::bf_hi(o1.f) + w2 * pg8::bf_hi(o2.f); \
                 const float z0 = pg8::bf_lo(zz.f), z1 = pg8::bf_hi(zz.f); r.f = pk2(e0 * z0 * pg8::sigmoid_f(z0), e1 * z1 * pg8::sigmoid_f(z1)); }
                MRG1(x) MRG1(y) MRG1(z) MRG1(w)
#undef MRG1
                *(GAS v4u*)(A2 + ((size_t)b * SEQ + t) * D + c) = r; }
        }
        xcd_barrier(bar);
    }

    {
        bf16* const H3B = (bf16*)(WSP + WS_H3B); bf16* const U1 = (bf16*)(WSP + WS_U1);
        pg8::Gemm g{A2, W_DOUT, M, D, D}; pg8::StaticOrder S; S.init(M, D, G, bx);
        pg8::EpiResid E{HRES, HRES, H3B};
#ifndef NO_G6
        pg8::gemm_phase<pg8::EpiResid, pg8::StaticOrder, true, true>(ldsl + RING_OFF, g, S, E, wave);
#endif
        int kple = PLE; asm volatile("" : "+s"(kple));
        pg8::Gemm g2{PB1, W_UP1, M, D, kple}; pg8::StaticOrder S2; S2.init(M, D, G, bx);
        pg8::EpiBf16<0> E2{U1, D, nullptr, 0, 0, 1.f};
#ifndef NO_G7
        pg8::gemm_phase<pg8::EpiBf16<0>, pg8::StaticOrder, true, true>(ldsl + RING_OFF, g2, S2, E2, wave);
#endif
        xcd_barrier(bar);
        pg8::Gemm g3{H3B, W_G1, M, D, D}; pg8::StaticOrder S3; S3.init(M, D, G, bx);
        pg8::EpiGate E3{HRES, U1, nullptr, nullptr, nullptr};
#ifndef NO_G8
        pg8::gemm_phase<pg8::EpiGate, pg8::StaticOrder, true, true>(ldsl + RING_OFF, g3, S3, E3, wave);
#endif
    }
    xcd_barrier(bar);

    {
        FRESH_TID();
        f32x4 g4[4];
#pragma unroll
        for (int j = 0; j < 4; ++j) g4[j] = *(const GAS f32x4*)(IN_FINORM + 4 * lane + 256 * j);
        for (int m = gw; m < M; m += NGW) {
            f32x4 v[4]; float s2 = 0.f; GAS f32x4* row = (GAS f32x4*)(HRES + (size_t)m * D) + lane;
#pragma unroll
            for (int j = 0; j < 4; ++j) { v[j] = row[64 * j]; s2 += (v[j].x * v[j].x + v[j].y * v[j].y) + (v[j].z * v[j].z + v[j].w * v[j].w); }
            const float rstd = 1.0f / sqrtf(wave_sum(s2) * (1.f / D) + RMS_EPS);
#pragma unroll
            for (int j = 0; j < 4; ++j) row[64 * j] = v[j] * rstd * g4[j];
        }
    }
}

extern "C" void kernel_launch(void* const* d_in, const int* in_sizes, int n_in, void* d_out, int out_size, void* d_ws, size_t ws_size, hipStream_t stream) {
    static int grid = 0;
    if (grid == 0) {
        if (n_in != 12 || in_sizes[0] != M * D || out_size != M * D || ws_size < WS_END) { fprintf(stderr, "kernel_launch: unexpected shapes (n_in %d, in0 %d, out %d, ws %zu); nothing launched\n", n_in, n_in > 0 ? in_sizes[0] : -1, out_size, ws_size); grid = -1; return; }
        int dev = 0, cus = 0, per_cu = 0;
        if (hipGetDevice(&dev) != hipSuccess || hipDeviceGetAttribute(&cus, hipDeviceAttributeMultiprocessorCount, dev) != hipSuccess) { grid = -1; return; }
        if (hipFuncSetAttribute((const void*)trunk_fwd, hipFuncAttributeMaxDynamicSharedMemorySize, LDS_BYTES) != hipSuccess) { fprintf(stderr, "kernel_launch: hipFuncSetAttribute failed\n"); grid = -1; return; }
        if (hipOccupancyMaxActiveBlocksPerMultiprocessor(&per_cu, (const void*)trunk_fwd, NWAVES * 64, LDS_BYTES) != hipSuccess || per_cu < 1) { fprintf(stderr, "kernel_launch: occupancy query says %d\n", per_cu); per_cu = 1; }
        (void)hipGetLastError();
        grid = cus;
        if (grid != 256) fprintf(stderr, "kernel_launch: %d CUs; the one-unit-per-CU GEMM phases assume 256\n", grid);
    }
    if (grid < 0) return;
    (void)hipMemsetAsync((char*)d_ws + WS_CTL, 0, CTL_ZERO_BYTES, stream);
    Args a{};
    for (int i = 0; i < 12; ++i) a.in[i] = (const float*)d_in[i];
    a.out = (float*)d_out; a.ws = (unsigned char*)d_ws;
    void* kargs[] = {&a};
    const hipError_t le = hipLaunchCooperativeKernel((const void*)trunk_fwd, dim3(grid), dim3(NWAVES * 64), kargs, LDS_BYTES, stream);
    if (le != hipSuccess) fprintf(stderr, "kernel_launch: cooperative launch failed: %s (grid %d)\n", hipGetErrorName(le), grid);
}
```

```cpp
#include <hip/hip_cooperative_groups.h>
#include <hip/hip_runtime.h>
#include <cstdio>
#include <cstdint>
__device__ __forceinline__ int lane_id_() { return (int)__builtin_amdgcn_mbcnt_hi(~0u, __builtin_amdgcn_mbcnt_lo(~0u, 0u)); }
template <int K> __device__ __forceinline__ float shx(float v) { static_assert(K >= 1 && K < 32, "shx: xor within a 32-lane half"); return __uint_as_float((unsigned)__builtin_amdgcn_ds_swizzle((int)__float_as_uint(v), 0x1f | (K << 10))); }
__device__ __forceinline__ float sum32(float v) { auto r = __builtin_amdgcn_permlane32_swap(__float_as_uint(v), __float_as_uint(v), false, false); return __uint_as_float(r[0]) + __uint_as_float(r[1]); }
__device__ __forceinline__ float max32(float v) { auto r = __builtin_amdgcn_permlane32_swap(__float_as_uint(v), __float_as_uint(v), false, false); return fmaxf(__uint_as_float(r[0]), __uint_as_float(r[1])); }
__device__ __forceinline__ float wave_sum(float v) { v += shx<1>(v); v += shx<2>(v); v += shx<4>(v); v += shx<8>(v); v += shx<16>(v); return sum32(v); }
namespace pg8 {
#define PG8_LAS __attribute__((address_space(3)))
typedef unsigned short bf16_t;
typedef short bf16x8 __attribute__((ext_vector_type(8)));
typedef float f32x4 __attribute__((ext_vector_type(4)));
typedef unsigned u32x4 __attribute__((ext_vector_type(4)));
constexpr int BM = 256, BK = 64, HALF = 128, HTB = HALF * BK * 2  , STAGE_BYTES = 8 * HTB, NXCD = 8, WGM = 8;

__host__ __device__ __forceinline__ int lds_byte(int r, int c) { const int st = (r >> 4) * 2 + (c >> 5), rr = r & 15, cc = c & 31, ob = rr * 64 + cc * 2; return st * 1024 + (ob ^ (((ob >> 9) & 1) << 5)); }
__host__ __device__ __forceinline__ void stage_rc(int b, int& R, int& C) { const int st = b / 1024, sb = b % 1024, swz = sb ^ (((sb >> 9) & 1) << 5); R = (st >> 1) * 16 + swz / 64; C = (st & 1) * 32 + (swz % 64) / 2; }
__host__ __device__ __forceinline__ int perm32(int rho) { const int n = rho >> 4, i = rho & 15; return 8 * (i >> 2) + 4 * n + (i & 3); }

struct Unit { int pm, pn; };
struct Gemm { const bf16_t* A; const bf16_t* Bt; int M, N, K; };

struct StaticOrder {
    int nM, nN, nwg, G, c;
    __host__ __device__ void init(int M, int N, int G_, int c_) { nM = M / BM; nN = N / BM; nwg = nM * nN; G = G_; c = c_; }
    __host__ __device__ bool next(int i, Unit& u) const {
        const long L = (long)i * G + c; if (L >= nwg) return false;
        int wgid = (int)L; { const int q = nwg / NXCD, r = nwg % NXCD, xcd = wgid % NXCD, off = wgid / NXCD; wgid = (xcd < r ? xcd * (q + 1) : r * (q + 1) + (xcd - r) * q) + off; }
        const int nig = WGM * nN, gid = wgid / nig, fm = gid * WGM, gsz = (nM - fm) < WGM ? (nM - fm) : WGM;
        u.pm = fm + ((wgid % nig) % gsz); u.pn = (wgid % nig) / gsz; return true;
    }
    __device__ __forceinline__ void a_ready(const Unit&) const {}
    __device__ __forceinline__ void done(const Unit&) const {}
};

__device__ __forceinline__ unsigned cvt_pk_bf16(float lo, float hi) { unsigned r; asm volatile("v_cvt_pk_bf16_f32 %0, %1, %2" : "=v"(r) : "v"(lo), "v"(hi)); return r; }
typedef float f32x2 __attribute__((ext_vector_type(2)));
__device__ __forceinline__ f32x2 gelu_pk(f32x2 v) {
    const f32x2 av = __builtin_elementwise_abs(v), d = av * 0.2316418882f + 1.0f;
    f32x2 t; t.x = __builtin_amdgcn_rcpf(d.x); t.y = __builtin_amdgcn_rcpf(d.y);
    f32x2 q = t * 0.5307027145f + (-0.7265760135f); q = q * t + 0.7107068705f; q = q * t + (-0.142248368f); q = q * t + 0.127414796f; q = q * t;
    const f32x2 s = (v * v) * (-0.72134752044f);
    f32x2 e; e.x = __builtin_amdgcn_exp2f(s.x); e.y = __builtin_amdgcn_exp2f(s.y);
    const f32x2 m = v * (q * e), r = v - m;
    f32x2 o; o.x = v.x < 0.f ? m.x : r.x; o.y = v.y < 0.f ? m.y : r.y; return o;
}

template <int ACT  > struct EpiBf16 {
    static constexpr bool PERM = true, AFTER_DRAIN = false; static_assert(ACT == 0 || ACT == 1, "EpiBf16: ACT is 0 (none) or 1 (gelu_pk)");
    bf16_t* O; int ldc; const float* bias; int split_cols; size_t split_stride; float scale0;
    __device__ __forceinline__ void operator()(const f32x4 (&acc)[2][2][4][2], const Unit& u, int wr, int wc, int fr, int fq) const {
        const int row0 = u.pm * BM + wr * 64 + fr; int colt = u.pn * BM; bf16_t* base = O;
        float sc = 1.f; if (split_cols) { const int t = colt / split_cols; base += (size_t)t * split_stride; colt -= t * split_cols; if (t == 0) sc = scale0; }
        const int col0 = colt + wc * 32 + 8 * fq, bcol0 = u.pn * BM + wc * 32 + 8 * fq;
        f32x4 bv[2][2];
#pragma unroll
        for (int bj = 0; bj < 2; ++bj)
#pragma unroll
            for (int n = 0; n < 2; ++n) bv[bj][n] = bias ? *(const f32x4*)(bias + bcol0 + bj * HALF + 4 * n) : (f32x4){0.f, 0.f, 0.f, 0.f};
#pragma unroll
        for (int ai = 0; ai < 2; ++ai)
#pragma unroll
            for (int m = 0; m < 4; ++m) { bf16_t* rowp = base + (size_t)(row0 + ai * HALF + m * 16) * ldc + col0;
#pragma unroll
                for (int bj = 0; bj < 2; ++bj) { f32x4 v0 = acc[ai][bj][m][0] + bv[bj][0], v1 = acc[ai][bj][m][1] + bv[bj][1];
                    if (ACT == 1) { f32x2 a = gelu_pk((f32x2){v0[0], v0[1]}), b = gelu_pk((f32x2){v0[2], v0[3]}), c = gelu_pk((f32x2){v1[0], v1[1]}), d = gelu_pk((f32x2){v1[2], v1[3]});
                        v0 = (f32x4){a.x, a.y, b.x, b.y}; v1 = (f32x4){c.x, c.y, d.x, d.y}; }
                    v0 = v0 * sc; v1 = v1 * sc; u32x4 w; w.x = cvt_pk_bf16(v0[0], v0[1]); w.y = cvt_pk_bf16(v0[2], v0[3]); w.z = cvt_pk_bf16(v1[0], v1[1]); w.w = cvt_pk_bf16(v1[2], v1[3]);
                    *(u32x4*)(rowp + bj * HALF) = w; } }
    }
};

__device__ __forceinline__ u32x4 pack8(const f32x4& v0, const f32x4& v1) { u32x4 w; w.x = cvt_pk_bf16(v0[0], v0[1]); w.y = cvt_pk_bf16(v0[2], v0[3]); w.z = cvt_pk_bf16(v1[0], v1[1]); w.w = cvt_pk_bf16(v1[2], v1[3]); return w; }
__device__ __forceinline__ float bf_lo(unsigned w) { return __uint_as_float(w << 16); }
__device__ __forceinline__ float bf_hi(unsigned w) { return __uint_as_float(w & 0xffff0000u); }
__device__ __forceinline__ float sigmoid_f(float x) { return __builtin_amdgcn_rcpf(1.0f + __builtin_amdgcn_exp2f(-1.4426950408889634f * x)); }

struct EpiFoxIn {
    static constexpr bool PERM = true, AFTER_DRAIN = false;
    bf16_t* O; size_t stride; float c2; unsigned* nm;
    __device__ __forceinline__ void operator()(const f32x4 (&acc)[2][2][4][2], const Unit& u, int wr, int wc, int fr, int fq) const {
        const int t = u.pn >> 2; bf16_t* base = O + (size_t)t * stride; const float sc = t == 0 ? c2 : 1.f;
        const int row0 = u.pm * BM + wr * 64 + fr, col0 = (u.pn & 3) * BM + wc * 32 + 8 * fq;
        float mx0 = 0.f, mx1 = 0.f;
#pragma unroll
        for (int ai = 0; ai < 2; ++ai)
#pragma unroll
            for (int m = 0; m < 4; ++m) { bf16_t* rowp = base + (size_t)(row0 + ai * HALF + m * 16) * 1024 + col0;
#pragma unroll
                for (int bj = 0; bj < 2; ++bj) { const f32x4 v0 = acc[ai][bj][m][0] * sc, v1 = acc[ai][bj][m][1] * sc;
                    *(u32x4*)(rowp + bj * HALF) = pack8(v0, v1);
                    if (t < 2) { float sq = (v0[0] * v0[0] + v0[1] * v0[1]) + (v0[2] * v0[2] + v0[3] * v0[3]) + (v1[0] * v1[0] + v1[1] * v1[1]) + (v1[2] * v1[2] + v1[3] * v1[3]);
                        sq += shx<16>(sq); sq = sum32(sq); if (bj == 0) mx0 = fmaxf(mx0, sq); else mx1 = fmaxf(mx1, sq); } } }
        if (t < 2) {
            { mx0 = fmaxf(mx0, shx<1>(mx0)); mx1 = fmaxf(mx1, shx<1>(mx1)); mx0 = fmaxf(mx0, shx<2>(mx0)); mx1 = fmaxf(mx1, shx<2>(mx1)); mx0 = fmaxf(mx0, shx<4>(mx0)); mx1 = fmaxf(mx1, shx<4>(mx1)); mx0 = fmaxf(mx0, shx<8>(mx0)); mx1 = fmaxf(mx1, shx<8>(mx1)); }
            if (fr == 0 && fq == 0) { const int b = u.pm >> 5, hd = (u.pn & 3) * 4 + (wc >> 1); unsigned* p = nm + (((b * 2 + t) * 16 + hd) * 2 + (wc & 1));
                atomicMax(p, __float_as_uint(mx0 * 1.02f)); atomicMax(p + 4, __float_as_uint(mx1 * 1.02f)); } }
    }
};
struct EpiResid {
    static constexpr bool PERM = true, AFTER_DRAIN = false;
    const float* base; float* out; bf16_t* hb;
    __device__ __forceinline__ void operator()(const f32x4 (&acc)[2][2][4][2], const Unit& u, int wr, int wc, int fr, int fq) const {
        const int row0 = u.pm * BM + wr * 64 + fr, col0 = u.pn * BM + wc * 32 + 8 * fq;
#pragma unroll
        for (int ai = 0; ai < 2; ++ai)
#pragma unroll
            for (int m = 0; m < 4; ++m) { const size_t off = (size_t)(row0 + ai * HALF + m * 16) * 1024 + col0;
#pragma unroll
                for (int bj = 0; bj < 2; ++bj) { const f32x4 b0 = *(const f32x4*)(base + off + bj * HALF), b1 = *(const f32x4*)(base + off + bj * HALF + 4);
                    const f32x4 v0 = acc[ai][bj][m][0] + b0, v1 = acc[ai][bj][m][1] + b1;
                    if (out) { *(f32x4*)(out + off + bj * HALF) = v0; *(f32x4*)(out + off + bj * HALF + 4) = v1; }
                    *(u32x4*)(hb + off + bj * HALF) = pack8(v0, v1); }
                asm volatile("" ::: "memory"); }
    }
};
struct EpiGate {
    static constexpr bool PERM = true, AFTER_DRAIN = false;
    float* h; const bf16_t* hb; const bf16_t* U; bf16_t* a1; const float* g; float* ss;
    __device__ __forceinline__ void operator()(const f32x4 (&acc)[2][2][4][2], const Unit& u, int wr, int wc, int fr, int fq) const {
        const int row0 = u.pm * BM + wr * 64 + fr, col0 = u.pn * BM + wc * 32 + 8 * fq;
        f32x4 gv[2][2];
#pragma unroll
        for (int bj = 0; bj < 2; ++bj)
#pragma unroll
            for (int n = 0; n < 2; ++n) gv[bj][n] = a1 ? *(const f32x4*)(g + col0 + bj * HALF + 4 * n) : (f32x4){0.f, 0.f, 0.f, 0.f};
#pragma unroll
        for (int ai = 0; ai < 2; ++ai)
#pragma unroll
            for (int m = 0; m < 4; ++m) { const int row = row0 + ai * HALF + m * 16; const size_t off = (size_t)row * 1024 + col0; float sq = 0.f;
#pragma unroll
                for (int bj = 0; bj < 2; ++bj) { const u32x4 hh = *(const u32x4*)(hb + off + bj * HALF);
                    const f32x4 h0 = (f32x4){bf_lo(hh.x), bf_hi(hh.x), bf_lo(hh.y), bf_hi(hh.y)}, h1 = (f32x4){bf_lo(hh.z), bf_hi(hh.z), bf_lo(hh.w), bf_hi(hh.w)};
                    const u32x4 uu = *(const u32x4*)(U + off + bj * HALF);
                    const f32x4 a0 = acc[ai][bj][m][0], a1v = acc[ai][bj][m][1];
                    f32x4 v0, v1;
                    v0[0] = h0[0] + bf_lo(uu.x) * sigmoid_f(a0[0]); v0[1] = h0[1] + bf_hi(uu.x) * sigmoid_f(a0[1]);
                    v0[2] = h0[2] + bf_lo(uu.y) * sigmoid_f(a0[2]); v0[3] = h0[3] + bf_hi(uu.y) * sigmoid_f(a0[3]);
                    v1[0] = h1[0] + bf_lo(uu.z) * sigmoid_f(a1v[0]); v1[1] = h1[1] + bf_hi(uu.z) * sigmoid_f(a1v[1]);
                    v1[2] = h1[2] + bf_lo(uu.w) * sigmoid_f(a1v[2]); v1[3] = h1[3] + bf_hi(uu.w) * sigmoid_f(a1v[3]);
                    *(f32x4*)(h + off + bj * HALF) = v0; *(f32x4*)(h + off + bj * HALF + 4) = v1;
                    if (a1) { *(u32x4*)(a1 + off + bj * HALF) = pack8(v0 * gv[bj][0], v1 * gv[bj][1]);
                        sq += (v0[0] * v0[0] + v0[1] * v0[1]) + (v0[2] * v0[2] + v0[3] * v0[3]) + (v1[0] * v1[0] + v1[1] * v1[1]) + (v1[2] * v1[2] + v1[3] * v1[3]); } }
                if (a1) { sq += shx<16>(sq); sq = sum32(sq); if (fq == 0) ss[(size_t)row * 16 + u.pn * 4 + wc] = sq; }
                asm volatile("" ::: "memory"); }
    }
};
struct EpiIn1 {
    static constexpr bool PERM = true, AFTER_DRAIN = false;
    bf16_t* q; bf16_t* k; bf16_t* v; bf16_t* z; const float* ss; float c2d, eps;
    __device__ __forceinline__ void operator()(const f32x4 (&acc)[2][2][4][2], const Unit& u, int wr, int wc, int fr, int fq) const {
        const int row0 = u.pm * BM + wr * 64 + fr; const int t = u.pn / 12;
        bf16_t* base = t == 0 ? q : t == 1 ? k : t == 2 ? v : z; const int ldc = t < 3 ? 3072 : 1024; const float sc = t == 0 ? c2d : 1.f;
        const int col0 = (u.pn - 12 * t) * BM + wc * 32 + 8 * fq;
#pragma unroll
        for (int ai = 0; ai < 2; ++ai)
#pragma unroll
            for (int m = 0; m < 4; ++m) { const int row = row0 + ai * HALF + m * 16;
                const f32x4* sp = (const f32x4*)(ss + (size_t)row * 16); const f32x4 s0 = sp[0], s1 = sp[1], s2 = sp[2], s3 = sp[3];
                const float tot = ((s0[0] + s0[1]) + (s0[2] + s0[3])) + ((s1[0] + s1[1]) + (s1[2] + s1[3])) + ((s2[0] + s2[1]) + (s2[2] + s2[3])) + ((s3[0] + s3[1]) + (s3[2] + s3[3]));
                const float rs = __builtin_amdgcn_rsqf(tot * (1.0f / 1024.0f) + eps) * sc;
                bf16_t* rowp = base + (size_t)row * ldc + col0;
#pragma unroll
                for (int bj = 0; bj < 2; ++bj) *(u32x4*)(rowp + bj * HALF) = pack8(acc[ai][bj][m][0] * rs, acc[ai][bj][m][1] * rs);
                asm volatile("" ::: "memory"); }
    }
};

template <class Epi, class Sched, bool ALIGN_EPI = false, bool SP2 = false>
__device__ __forceinline__ void gemm_phase(PG8_LAS unsigned char* lds, const Gemm g, const Sched& S, const Epi& E, const int wave_id) {
    int tid_ = wave_id * 64 + lane_id_(); asm volatile("" : "+v"(tid_));
    const int tid = tid_, wid = __builtin_amdgcn_readfirstlane(tid >> 6), lane = tid & 63, wr = wid >> 2, wc = wid & 3, fr = lane & 15, fq = lane >> 4;
    const int K = g.K, nt = K / BK;
    unsigned voffA[2], voffB[2];
#pragma unroll
    for (int i = 0; i < 2; ++i) { int R, C; stage_rc(tid * 16 + i * 8192, R, C); const int Rb = Epi::PERM ? ((R & ~31) + perm32(R & 31)) : R;
        voffA[i] = (unsigned)(R * K + C) * 2u; voffB[i] = (unsigned)(Rb * K + C) * 2u; }
    const size_t kstep = (size_t)(BK * 2);
    const size_t hstep = (size_t)HALF * K * 2;
    const size_t tstep = 2 * hstep;
    const unsigned ldsw = (unsigned)wid * 1024u;
    const int aoff = lds_byte(wr * 64 + fr, fq * 8), boff = lds_byte(wc * 32 + fr, fq * 8);
#define PG8_SA(b, h) (((b) * 2 + (h)) * HTB)
#define PG8_SB(b, h) ((4 + (b) * 2 + (h)) * HTB)
#define PG8_STAGE(bufoff, gbase, voff) do { _Pragma("unroll") for (int _i = 0; _i < 2; ++_i) \
        __builtin_amdgcn_global_load_lds((const unsigned*)((const char*)(gbase) + (voff)[_i]), (PG8_LAS unsigned*)(lds + (bufoff) + ldsw + _i * 8192), 16, 0, 0); } while (0)
#define PG8_LDA(dst, b, h) do { _Pragma("unroll") for (int m = 0; m < 4; ++m) _Pragma("unroll") for (int k = 0; k < 2; ++k) dst[m][k] = *(const PG8_LAS bf16x8*)(lds + PG8_SA(b, h) + aoff + m * 2048 + k * 1024); } while (0)
#define PG8_LDB(dst, b, h) do { _Pragma("unroll") for (int n = 0; n < 2; ++n) _Pragma("unroll") for (int k = 0; k < 2; ++k) dst[n][k] = *(const PG8_LAS bf16x8*)(lds + PG8_SB(b, h) + boff + n * 2048 + k * 1024); } while (0)
#define PG8_MMA(ai, bj, At, Bt) do { __builtin_amdgcn_s_setprio(1); _Pragma("unroll") for (int m = 0; m < 4; ++m) _Pragma("unroll") for (int n = 0; n < 2; ++n) _Pragma("unroll") for (int k = 0; k < 2; ++k) \
        acc[ai][bj][m][n] = __builtin_amdgcn_mfma_f32_16x16x32_bf16(Bt[n][k], At[m][k], acc[ai][bj][m][n], 0, 0, 0); __builtin_amdgcn_s_setprio(0); } while (0)
#define PG8_WAIT_V(n) asm volatile("s_waitcnt vmcnt(" #n ")" ::: "memory")
#define PG8_WAIT_L(n) asm volatile("s_waitcnt lgkmcnt(" #n ")" ::: "memory")
#define PG8_BAR __builtin_amdgcn_s_barrier()
#define PG8_SCHED __builtin_amdgcn_sched_barrier(0)
    Unit cur, nxt; int ui = 0;
    if (!S.next(0, cur)) return;
    f32x4 acc[2][2][4][2];
#pragma unroll
    for (int a = 0; a < 2; ++a)
#pragma unroll
        for (int b = 0; b < 2; ++b)
#pragma unroll
            for (int m = 0; m < 4; ++m)
#pragma unroll
                for (int n = 0; n < 2; ++n) acc[a][b][m][n] = (f32x4){0.f, 0.f, 0.f, 0.f};
    bf16x8 At[4][2], B0[2][2], B1[2][2];
    const char* cA = (const char*)g.A + (size_t)cur.pm * tstep; const char* cB = (const char*)g.Bt + (size_t)cur.pn * tstep;
    S.a_ready(cur);
    if constexpr (SP2) {
        PG8_STAGE(PG8_SB(0, 0), cB, voffB); PG8_STAGE(PG8_SB(0, 1), cB + hstep, voffB); PG8_STAGE(PG8_SA(0, 0), cA, voffA); PG8_STAGE(PG8_SA(0, 1), cA + hstep, voffA);
        if (wr == 1) PG8_BAR;
        PG8_WAIT_V(2); PG8_BAR;
        PG8_STAGE(PG8_SB(1, 0), cB + kstep, voffB); PG8_STAGE(PG8_SA(1, 0), cA + kstep, voffA); PG8_STAGE(PG8_SB(1, 1), cB + hstep + kstep, voffB);
        PG8_WAIT_V(6); PG8_BAR;
    } else {
        PG8_STAGE(PG8_SB(0, 0), cB, voffB); PG8_STAGE(PG8_SA(0, 0), cA, voffA); PG8_STAGE(PG8_SB(0, 1), cB + hstep, voffB); PG8_STAGE(PG8_SA(0, 1), cA + hstep, voffA);
        if (wr == 1) PG8_BAR;
        PG8_WAIT_V(4); PG8_BAR;
        PG8_STAGE(PG8_SB(1, 0), cB + kstep, voffB); PG8_STAGE(PG8_SA(1, 0), cA + kstep, voffA); PG8_STAGE(PG8_SB(1, 1), cB + hstep + kstep, voffB);
        PG8_WAIT_V(6); PG8_BAR;
    }
    for (;;) {
        const bool has_next = S.next(ui + 1, nxt);
        const char* nA = has_next ? (const char*)g.A + (size_t)nxt.pm * tstep : cA; const char* nB = has_next ? (const char*)g.Bt + (size_t)nxt.pn * tstep : cB;
        for (int t = 0; t < nt; t += 2) {
            const bool last = (t == nt - 2);
            const char* a1 = cA + (size_t)(t + 1) * kstep;
            const char* a2 = last ? nA : cA + (size_t)(t + 2) * kstep; const char* b2 = last ? nB : cB + (size_t)(t + 2) * kstep;
            const char* a3 = a2 + kstep; const char* b3 = b2 + kstep;
            if (last && has_next) S.a_ready(nxt);
            if constexpr (SP2) {
            PG8_LDB(B0, 0, 0); PG8_LDB(B1, 0, 1); PG8_SCHED; PG8_LDA(At, 0, 0); PG8_STAGE(PG8_SA(1, 1), a1 + hstep, voffA);
            PG8_WAIT_V(8); PG8_WAIT_L(0); PG8_BAR; PG8_MMA(0, 0, At, B0); PG8_MMA(0, 1, At, B1); PG8_BAR; PG8_SCHED;
            PG8_LDA(At, 0, 1); PG8_STAGE(PG8_SB(0, 0), b2, voffB); PG8_STAGE(PG8_SB(0, 1), b2 + hstep, voffB); PG8_STAGE(PG8_SA(0, 0), a2, voffA);
            PG8_WAIT_V(8); PG8_WAIT_L(0); PG8_BAR; PG8_MMA(1, 0, At, B0); PG8_MMA(1, 1, At, B1); PG8_BAR; PG8_SCHED;
            PG8_LDB(B0, 1, 0); PG8_LDB(B1, 1, 1); PG8_SCHED; PG8_LDA(At, 1, 0); PG8_STAGE(PG8_SA(0, 1), a2 + hstep, voffA);
            PG8_WAIT_V(8); PG8_WAIT_L(0); PG8_BAR; PG8_MMA(0, 0, At, B0); PG8_MMA(0, 1, At, B1); PG8_BAR; PG8_SCHED;
            PG8_LDA(At, 1, 1); PG8_STAGE(PG8_SB(1, 0), b3, voffB); PG8_STAGE(PG8_SB(1, 1), b3 + hstep, voffB); PG8_STAGE(PG8_SA(1, 0), a3, voffA);
            PG8_WAIT_V(8); PG8_WAIT_L(0); PG8_BAR; PG8_MMA(1, 0, At, B0); PG8_MMA(1, 1, At, B1); PG8_BAR; PG8_SCHED;
            } else {
            PG8_LDB(B0, 0, 0); PG8_SCHED; PG8_LDA(At, 0, 0); PG8_STAGE(PG8_SA(1, 1), a1 + hstep, voffA);
            PG8_WAIT_L(8); PG8_BAR; PG8_WAIT_L(0); PG8_MMA(0, 0, At, B0); PG8_BAR; PG8_SCHED;
            PG8_LDB(B1, 0, 1); PG8_STAGE(PG8_SB(0, 0), b2, voffB);
            PG8_BAR; PG8_WAIT_L(0); PG8_MMA(0, 1, At, B1); PG8_BAR;
            PG8_LDA(At, 0, 1); PG8_STAGE(PG8_SA(0, 0), a2, voffA);
            PG8_BAR; PG8_WAIT_L(0); PG8_MMA(1, 0, At, B0); PG8_BAR; PG8_SCHED;
            PG8_STAGE(PG8_SB(0, 1), b2 + hstep, voffB);
            PG8_WAIT_V(6); PG8_BAR; PG8_MMA(1, 1, At, B1); PG8_BAR;
            PG8_LDB(B0, 1, 0); PG8_SCHED; PG8_LDA(At, 1, 0); PG8_STAGE(PG8_SA(0, 1), a2 + hstep, voffA);
            PG8_WAIT_L(8); PG8_BAR; PG8_WAIT_L(0); PG8_MMA(0, 0, At, B0); PG8_BAR; PG8_SCHED;
            PG8_LDB(B1, 1, 1); PG8_STAGE(PG8_SB(1, 0), b3, voffB);
            PG8_BAR; PG8_WAIT_L(0); PG8_MMA(0, 1, At, B1); PG8_BAR;
            PG8_LDA(At, 1, 1); PG8_STAGE(PG8_SA(1, 0), a3, voffA);
            PG8_BAR; PG8_WAIT_L(0); PG8_MMA(1, 0, At, B0); PG8_BAR; PG8_SCHED;
            PG8_STAGE(PG8_SB(1, 1), b3 + hstep, voffB);
            PG8_WAIT_V(6); PG8_BAR; PG8_MMA(1, 1, At, B1); PG8_BAR;
            }
        }
        if constexpr (ALIGN_EPI) { if (wr == 0) PG8_BAR; }
        if constexpr (!Epi::AFTER_DRAIN) { E(acc, cur, wr, wc, fr, fq); S.done(cur); }
        if (!has_next) break;
#pragma unroll
        for (int a = 0; a < 2; ++a)
#pragma unroll
            for (int b = 0; b < 2; ++b)
#pragma unroll
                for (int m = 0; m < 4; ++m)
#pragma unroll
                    for (int n = 0; n < 2; ++n) acc[a][b][m][n] = (f32x4){0.f, 0.f, 0.f, 0.f};
        cur = nxt; cA = nA; cB = nB; ++ui;
        if constexpr (ALIGN_EPI) { if (wr == 1) PG8_BAR; }
    }
    PG8_WAIT_V(0);
    if constexpr (!ALIGN_EPI) { if (wr == 0) PG8_BAR; }
    PG8_BAR;
    if constexpr (Epi::AFTER_DRAIN) { E.fused(acc, cur, wr, wc, fr, fq, lds, wid, lane); S.done(cur); }
#undef PG8_SA
#undef PG8_SB
#undef PG8_STAGE
#undef PG8_LDA
#undef PG8_LDB
#undef PG8_MMA
#undef PG8_WAIT_V
#undef PG8_WAIT_L
#undef PG8_BAR
#undef PG8_SCHED
}
}
#include <hip/hip_bf16.h>
#include <cmath>
namespace attn_body {
using bf16=__hip_bfloat16;
using bf16x8=__attribute__((ext_vector_type(8)))short;
using s16x4=__attribute__((ext_vector_type(4)))short;
using f32x16=__attribute__((ext_vector_type(16)))float;
using u32x4=__attribute__((ext_vector_type(4)))unsigned;
constexpr int BATCH=2,NHEAD=16,SEQ=8192,D=64,DM=NHEAD*D;
constexpr int NW=8,QBLK=32,QB=QBLK*NW,KVBLK=64,NQB=SEQ/QB;
constexpr int ATTN_PITCH=DM, ATTN_UNIT_ROWS=QB;
__device__ __forceinline__ int crow(int r,int hi){return (r&3)+8*(r>>2)+4*hi;}
#define SBAR() __builtin_amdgcn_sched_barrier(0)
__device__ __forceinline__ void cmask(f32x16&p0,f32x16&p1,int jb,int qrel,int hi){
  const float NEG=-INFINITY; int kb=64*jb+4*hi;
  #pragma unroll
  for(int r=0;r<16;++r){int kv=kb+(r&3)+8*(r>>2); if(kv>qrel)p0[r]=NEG; if(kv+32>qrel)p1[r]=NEG;}
}

typedef float f32x4_t __attribute__((ext_vector_type(4)));
constexpr int NSLOT=3, SLOTB=8192;
constexpr int LDS_K=0, LDS_V=NSLOT*SLOTB, LDS_WS=2*NSLOT*SLOTB, LDS_OST=LDS_WS+NW*64*4, LDS_CT=LDS_OST+NW*4096, LDS_BYTES=LDS_CT+SEQ*4;
constexpr float C2=0.125f*1.4426950408889634f;
__device__ __forceinline__ void glds16(const void*gsrc,unsigned lds_dst){unsigned keep;
  asm volatile("s_mov_b32 %0, m0\n\ts_mov_b32 m0, %2\n\ts_nop 0\n\tglobal_load_lds_dwordx4 %1, off\n\ts_mov_b32 m0, %0":"=&s"(keep):"v"(gsrc),"s"(lds_dst):"memory");}
__device__ __forceinline__ float max3f(float a,float b,float c){float r;asm("v_max3_f32 %0, %1, %2, %3":"=v"(r):"v"(a),"v"(b),"v"(c));return r;}
__device__ __forceinline__ float max2f(float a,float b){float r;asm("v_max_f32_e32 %0, %1, %2":"=v"(r):"v"(a),"v"(b));return r;}
__device__ __forceinline__ float fadd_s(float a,float b){float r;asm("v_add_f32_e32 %0, %1, %2":"=v"(r):"v"(a),"v"(b));return r;}
__device__ __forceinline__ float fsub_s(float a,float b){float r;asm("v_sub_f32_e32 %0, %1, %2":"=v"(r):"v"(a),"v"(b));return r;}
typedef float f32x2_t __attribute__((ext_vector_type(2))); typedef __bf16 bf16x2_t __attribute__((ext_vector_type(2)));
__device__ __forceinline__ unsigned cvtpk_s(float lo,float hi){f32x2_t v={lo,hi};bf16x2_t b=__builtin_convertvector(v,bf16x2_t);return __builtin_bit_cast(unsigned,b);}
__device__ __forceinline__ float silu_f(float z){return z*__builtin_amdgcn_rcpf(1.0f+__builtin_amdgcn_exp2f(-1.4426950408889634f*z));}
__device__ __forceinline__ unsigned gate2(unsigned o,unsigned z){ const float o0=__uint_as_float(o<<16),o1=__uint_as_float(o&0xffff0000u),z0=__uint_as_float(z<<16),z1=__uint_as_float(z&0xffff0000u); return cvtpk_s(o0*silu_f(z0),o1*silu_f(z1)); }
#define WAIT_BAR(N) asm volatile("s_waitcnt vmcnt(" #N ") lgkmcnt(0)\n\ts_barrier":::"memory")

__device__ __forceinline__ void qkt(f32x16&p0,f32x16&p1,const char*Kslot,const bf16x8*qr,const f32x16&negm,int r32,int hi){
  const char*kb=Kslot+hi*1024+r32*16;
  #pragma unroll
  for(int d0=0;d0<4;++d0){
    const bf16x8 b0=*reinterpret_cast<const bf16x8*>(kb+d0*2048);
    const bf16x8 b1=*reinterpret_cast<const bf16x8*>(kb+d0*2048+512);
    if(d0==0){p0=__builtin_amdgcn_mfma_f32_32x32x16_bf16(b0,qr[0],negm,0,0,0);p1=__builtin_amdgcn_mfma_f32_32x32x16_bf16(b1,qr[0],negm,0,0,0);}
    else{p0=__builtin_amdgcn_mfma_f32_32x32x16_bf16(b0,qr[d0],p0,0,0,0);p1=__builtin_amdgcn_mfma_f32_32x32x16_bf16(b1,qr[d0],p1,0,0,0);}}
}
typedef __attribute__((address_space(3))) const char* lds_cptr;
typedef short v4i16_t __attribute__((ext_vector_type(4)));
__device__ __forceinline__ void kload8(bf16x8*kf,lds_cptr kp){
  kf[0]=*(const __attribute__((address_space(3))) bf16x8*)(kp);      kf[1]=*(const __attribute__((address_space(3))) bf16x8*)(kp+512);
  kf[2]=*(const __attribute__((address_space(3))) bf16x8*)(kp+2048); kf[3]=*(const __attribute__((address_space(3))) bf16x8*)(kp+2560);
  kf[4]=*(const __attribute__((address_space(3))) bf16x8*)(kp+4096); kf[5]=*(const __attribute__((address_space(3))) bf16x8*)(kp+4608);
  kf[6]=*(const __attribute__((address_space(3))) bf16x8*)(kp+6144); kf[7]=*(const __attribute__((address_space(3))) bf16x8*)(kp+6656);
}
__device__ __forceinline__ void kload2(bf16x8*kf,lds_cptr kp,int j){ kf[2*j]=*(const __attribute__((address_space(3))) bf16x8*)(kp+j*2048); kf[2*j+1]=*(const __attribute__((address_space(3))) bf16x8*)(kp+j*2048+512); }
__device__ __forceinline__ s16x4 vtr(lds_cptr p){ return __builtin_bit_cast(s16x4,__builtin_amdgcn_ds_read_tr16_b64_v4i16((__attribute__((address_space(3))) v4i16_t*)p)); }
__device__ __forceinline__ float rowmax(const f32x16&p0,const f32x16&p1){
  float a=max3f(p0[0],p0[1],p1[0]),b=max3f(p0[2],p0[3],p1[1]);a=max3f(a,p1[2],p1[3]);
  #pragma unroll
  for(int r=4;r<16;r+=4){a=max3f(a,p0[r],p0[r+1]);b=max3f(b,p0[r+2],p0[r+3]);a=max3f(a,p1[r],p1[r+1]);b=max3f(b,p1[r+2],p1[r+3]);}
  const float m=max2f(a,b);
  auto rr=__builtin_amdgcn_permlane32_swap(__float_as_uint(m),__float_as_uint(m),false,false);
  return max2f(__uint_as_float(rr[0]),__uint_as_float(rr[1]));
}
__device__ __forceinline__ void pv(f32x16*o,int vb,bf16x8 pa0,bf16x8 pa1,bf16x8 pa2,bf16x8 pa3){
  #pragma unroll
  for(int d0=0;d0<2;++d0){s16x4 lo[4],hi[4];
    #pragma unroll
    for(int ks=0;ks<4;++ks){
      asm volatile("ds_read_b64_tr_b16 %0,%1 offset:%c2":"=&v"(lo[ks]):"v"(vb),"i"(d0*4096+ks*1024):"memory");
      asm volatile("ds_read_b64_tr_b16 %0,%1 offset:%c2":"=&v"(hi[ks]):"v"(vb),"i"(d0*4096+ks*1024+512):"memory");}
    asm volatile("s_waitcnt lgkmcnt(0)":::"memory");SBAR();
    #define PK(k) (bf16x8){lo[k][0],lo[k][1],lo[k][2],lo[k][3],hi[k][0],hi[k][1],hi[k][2],hi[k][3]}
    o[d0]=__builtin_amdgcn_mfma_f32_32x32x16_bf16(pa0,PK(0),o[d0],0,0,0);
    o[d0]=__builtin_amdgcn_mfma_f32_32x32x16_bf16(pa1,PK(1),o[d0],0,0,0);
    o[d0]=__builtin_amdgcn_mfma_f32_32x32x16_bf16(pa2,PK(2),o[d0],0,0,0);
    o[d0]=__builtin_amdgcn_mfma_f32_32x32x16_bf16(pa3,PK(3),o[d0],0,0,0);
    #undef PK
  }
}

#ifndef ATTN_STORE16
#define ATTN_STORE16(p,v) (*(u32x4*)(p)=(v))
#endif
template<int THRL> __device__ __forceinline__ void attn_unit(int b,int h,int qb,const bf16*Q,const bf16*__restrict__ K,const bf16*__restrict__ V,bf16*O,const bf16*__restrict__ Zg,const float*__restrict__ Cg,const unsigned*NMp,char*shm,const int wave_id,const bool do_store){
  int tid_=wave_id*64+lane_id_(); asm volatile("":"+v"(tid_)); const int tid=tid_,lane=tid&63,r32=lane&31,hi=lane>>5; const int wid=__builtin_amdgcn_readfirstlane(tid>>6);
  const long rowbase=(long)b*SEQ; const int q0=qb*QB;
  const bf16*Qw=Q+(rowbase+q0+wid*QBLK)*DM+h*D;
  const bf16*Kh=K+rowbase*DM+h*D,*Vh=V+rowbase*DM+h*D;
  const unsigned lds0=(unsigned)(uintptr_t)shm;
  float*wsf=(float*)(shm+LDS_WS)+wid*64;
  const bf16*ksrc=Kh+(long)lane*DM+wid*8;
  const bf16*vsrc=Vh+(long)(16*(wid&3)+(lane>>2))*DM+(wid>>2)*32+(lane&3)*8;
  const unsigned kdst=lds0+LDS_K+wid*1024, vdst=lds0+LDS_V+wid*1024;
  #define TILE(j) (NT-1-(j))
  #define DMA_K(t,slot) glds16(ksrc+(long)TILE(t)*KVBLK*DM,(unsigned)__builtin_amdgcn_readfirstlane(kdst+(slot)))
  #define DMA_V(t,slot) glds16(vsrc+(long)TILE(t)*KVBLK*DM,(unsigned)__builtin_amdgcn_readfirstlane(vdst+(slot)))
  const int vb0=(int)(lds0+LDS_V)+((lane>>4)&1)*32+(lane&3)*8+(4*hi+((lane&15)>>2))*64;
  const char*Kbase=shm+LDS_K; bf16x8 kf[8];
  const lds_cptr shm3=(lds_cptr)shm; const lds_cptr kp0=shm3+LDS_K+hi*1024+r32*16; const lds_cptr vp0=shm3+LDS_V+((lane>>4)&1)*32+(lane&3)*8+(4*hi+((lane&15)>>2))*64;
  const int NT=(q0+QB)/KVBLK;
  DMA_K(0,0);DMA_V(0,0);DMA_K(1,SLOTB);
  bf16x8 qr[4];
  #pragma unroll
  for(int d0=0;d0<4;++d0)qr[d0]=*reinterpret_cast<const bf16x8*>(&Qw[(long)r32*DM+d0*16+hi*8]);
  float mhat=0.f,l_reg=0.f;f32x16 o[2];o[0]=f32x16{};o[1]=f32x16{};f32x16 negm=f32x16{};asm volatile("":"+v"(negm));
  const int qrel=wid*QBLK+r32;
  #define CMASK(P0,P1,t) do{int jb_=3-(t); if(jb_>=0)cmask(P0,P1,jb_,qrel,hi);}while(0)
  #define CDEC(P0,P1,t) do{ const lds_f4ptr cb_=(lds_f4ptr)(ctab+64*TILE(t)+4*hi); \
    _Pragma("unroll") for(int g_=0;g_<4;++g_){ const f32x4_t a_=cb_[2*g_], b_=cb_[8+2*g_]; \
      P0[4*g_]-=a_[0];P0[4*g_+1]-=a_[1];P0[4*g_+2]-=a_[2];P0[4*g_+3]-=a_[3]; P1[4*g_]-=b_[0];P1[4*g_+1]-=b_[1];P1[4*g_+2]-=b_[2];P1[4*g_+3]-=b_[3]; } }while(0)
  bool resc=false;
  #define START(P0,P1) do{ const float rm=rowmax(P0,P1); resc=false; \
    { const float dl=(rm==-INFINITY)?0.f:rm; mhat=fadd_s(mhat,dl); \
      _Pragma("unroll") for(int r=0;r<16;++r){P0[r]=fsub_s(P0[r],dl);P1[r]=fsub_s(P1[r],dl);} \
      _Pragma("unroll") for(int r=0;r<16;++r)negm[r]=-mhat; asm volatile("":"+v"(negm)); } \
    _Pragma("unroll") for(int r=0;r<16;++r)P0[r]=__builtin_amdgcn_exp2f(P0[r]); }while(0)
  #define RESC() do{ if(resc){ asm volatile("s_waitcnt lgkmcnt(0)":::"memory"); \
      _Pragma("unroll") for(int d_=0;d_<2;++d_) _Pragma("unroll") for(int r=0;r<16;++r)o[d_][r]*=wsf[crow(r,hi)]; } }while(0)
  f32x16 pA0,pA1,pB0,pB1;
  int sl_prev=0,sl_cur=0,sl_next=SLOTB;
  #define ROT() do{sl_prev=sl_cur;sl_cur=sl_next;sl_next=(sl_next==(NSLOT-1)*SLOTB)?0:sl_next+SLOTB;}while(0)
  DMA_K(2,2*SLOTB);
  typedef __attribute__((address_space(3))) float* lds_fptr; typedef __attribute__((address_space(3))) const f32x4_t* lds_f4ptr;
  const lds_fptr ctab=(lds_fptr)(shm3+LDS_CT);
  { const float*cg=Cg+(long)(b*NHEAD+h)*SEQ; const float cref=cg[q0];
    for(int i=tid*4;i<q0+QB;i+=NW*64*4){ f32x4_t v=*(const f32x4_t*)(cg+i); v[0]-=cref;v[1]-=cref;v[2]-=cref;v[3]-=cref; *(__attribute__((address_space(3))) f32x4_t*)(ctab+i)=v; } }
  float thr; { const unsigned*nm=NMp+((b*2)*NHEAD+h)*2; const float qs=__uint_as_float(__hip_atomic_load(nm,__ATOMIC_RELAXED,__HIP_MEMORY_SCOPE_AGENT))+__uint_as_float(__hip_atomic_load(nm+1,__ATOMIC_RELAXED,__HIP_MEMORY_SCOPE_AGENT)),
      ks=__uint_as_float(__hip_atomic_load(nm+2*NHEAD,__ATOMIC_RELAXED,__HIP_MEMORY_SCOPE_AGENT))+__uint_as_float(__hip_atomic_load(nm+2*NHEAD+1,__ATOMIC_RELAXED,__HIP_MEMORY_SCOPE_AGENT)); thr=40.f+2.02f*sqrtf(qs*ks); }
  WAIT_BAR(3);
  int NTE; { const int tl0=NT-5-lane, tl1=tl0-64; const float c0_=tl0>=0?ctab[64*tl0+63]:3.0e38f, c1_=tl1>=0?ctab[64*tl1+63]:3.0e38f;
    NTE=4+__popcll(__ballot(c0_<=thr))+__popcll(__ballot(c1_<=thr)); NTE+=NTE&1; NTE=__builtin_amdgcn_readfirstlane(NTE); }
  mhat=-ctab[q0+wid*QBLK+r32];
  _Pragma("unroll") for(int r=0;r<16;++r)negm[r]=-mhat; asm volatile("":"+v"(negm));
  qkt(pA0,pA1,Kbase,qr,negm,r32,hi);asm volatile("s_nop 15\n\ts_nop 7":"+v"(pA0),"+v"(pA1));CDEC(pA0,pA1,0);CMASK(pA0,pA1,0);
  START(pA0,pA1);
  _Pragma("unroll") for(int r=0;r<16;++r)pA1[r]=__builtin_amdgcn_exp2f(pA1[r]);
  WAIT_BAR(0);
  DMA_K(3,0);DMA_V(1,SLOTB);
  ROT();
  kload8(kf,kp0+sl_cur);
  WAIT_BAR(2);
  s16x4 vlo[8],vhi[8]; u32x4 pw0,pw1,pw2,pw3;
  #define PKW(P,B) cvtpk_s(P[B],P[B+1])
  #define PAF(k) __builtin_bit_cast(bf16x8,pw##k)
  #define VFR(i) (bf16x8){vlo[i][0],vlo[i][1],vlo[i][2],vlo[i][3],vhi[i][0],vhi[i][1],vhi[i][2],vhi[i][3]}
  #define PIN(x) asm volatile("":"+v"(x))
  #define MX3(a,b,c) __builtin_fmaxf(__builtin_fmaxf((a),(b)),(c))
  #define GAPA(MF,A0,A1,A2,A3,W0,W1,PW) do{ MF; sacc+=A0; sacc+=A1; sacc+=A2; sacc+=A3; PIN(sacc); W0; W1; PIN(PW); SBAR(); }while(0)
  #define EX(v) __builtin_amdgcn_exp2f(v)
  #define GAPB(MF,X,B) do{ MF; X[B]=EX(X[B]); X[B+1]=EX(X[B+1]); X[B+2]=EX(X[B+2]); X[B+3]=EX(X[B+3]); PIN(X); SBAR(); }while(0)
  #define VRD(i) do{ vlo[i]=vtr(vp_+(((i)>>2)*4096+((i)&3)*1024)); vhi[i]=vtr(vp_+(((i)>>2)*4096+((i)&3)*1024+512)); }while(0)
  #define KRD(G,j) do{ if(G){ kload2(kf,kp0+sl_next,j); SBAR(); } }while(0)
  #define STEP(C0,C1,P0,P1,t,GK,GV,GL) do{ SBAR(); \
    const lds_cptr vp_=vp0+sl_prev; \
    VRD(0); SBAR(); float sacc=(P0[0]+P0[1]); \
    GAPA(C0=__builtin_amdgcn_mfma_f32_32x32x16_bf16(kf[0],qr[0],negm,0,0,0), P0[2],P0[3],P0[4],P0[5],     pw0[0]=PKW(P0,0), pw0[1]=PKW(P0,2), pw0); \
    VRD(4); SBAR(); GAPA(C1=__builtin_amdgcn_mfma_f32_32x32x16_bf16(kf[1],qr[0],negm,0,0,0), P0[6],P0[7],P0[8],P0[9],     pw0[2]=PKW(P0,4), pw0[3]=PKW(P0,6), pw0); \
    VRD(1); SBAR(); GAPA(C0=__builtin_amdgcn_mfma_f32_32x32x16_bf16(kf[2],qr[1],C0,0,0,0),   P0[10],P0[11],P0[12],P0[13], pw1[0]=PKW(P0,8), pw1[1]=PKW(P0,10), pw1); \
    VRD(5); SBAR(); GAPA(C1=__builtin_amdgcn_mfma_f32_32x32x16_bf16(kf[3],qr[1],C1,0,0,0),   P0[14],P0[15],P1[0],P1[1],   pw1[2]=PKW(P0,12),pw1[3]=PKW(P0,14), pw1); \
    VRD(2); SBAR(); GAPA(C0=__builtin_amdgcn_mfma_f32_32x32x16_bf16(kf[4],qr[2],C0,0,0,0),   P1[2],P1[3],P1[4],P1[5],     pw2[0]=PKW(P1,0), pw2[1]=PKW(P1,2), pw2); \
    VRD(6); SBAR(); GAPA(C1=__builtin_amdgcn_mfma_f32_32x32x16_bf16(kf[5],qr[2],C1,0,0,0),   P1[6],P1[7],P1[8],P1[9],     pw2[2]=PKW(P1,4), pw2[3]=PKW(P1,6), pw2); \
    VRD(3); SBAR(); GAPA(C0=__builtin_amdgcn_mfma_f32_32x32x16_bf16(kf[6],qr[3],C0,0,0,0),   P1[10],P1[11],P1[12],P1[13], pw3[0]=PKW(P1,8), pw3[1]=PKW(P1,10), pw3); \
    VRD(7); SBAR(); GAPA(C1=__builtin_amdgcn_mfma_f32_32x32x16_bf16(kf[7],qr[3],C1,0,0,0),   P1[14],P1[15],0.f,0.f,       pw3[2]=PKW(P1,12),pw3[3]=PKW(P1,14), pw3); \
    l_reg+=sacc; \
    if(GK){DMA_K((t)+3,sl_cur);} if(GV){DMA_V((t)+1,sl_next);} \
    CDEC(C0,C1,t); CMASK(C0,C1,t); \
    { float a=MX3(C0[0],C0[1],C1[0]),b=MX3(C0[2],C0[3],C1[1]); a=MX3(a,C1[2],C1[3]); \
      _Pragma("unroll") for(int r=4;r<16;r+=4){a=MX3(a,C0[r],C0[r+1]);b=MX3(b,C0[r+2],C0[r+3]);a=MX3(a,C1[r],C1[r+1]);b=MX3(b,C1[r+2],C1[r+3]);} \
      float rm=__builtin_fmaxf(a,b); { auto rr=__builtin_amdgcn_permlane32_swap(__float_as_uint(rm),__float_as_uint(rm),false,false); rm=__builtin_fmaxf(__uint_as_float(rr[0]),__uint_as_float(rr[1])); } \
      resc=false; \
      if(__builtin_expect(__any(rm>(float)THRL),0)){ const float dl=__builtin_fmaxf(rm,0.f); mhat+=dl; \
        _Pragma("unroll") for(int r=0;r<16;++r){C0[r]-=dl;C1[r]-=dl;} \
        _Pragma("unroll") for(int r=0;r<16;++r)negm[r]=-mhat; asm volatile("":"+v"(negm)); \
        const float f=__builtin_amdgcn_exp2f(-dl); l_reg*=f; if(hi==0)wsf[r32]=f; resc=true; } } \
    SBAR(); \
    GAPB(o[0]=__builtin_amdgcn_mfma_f32_32x32x16_bf16(PAF(0),VFR(0),o[0],0,0,0), C0,0); \
    GAPB(o[1]=__builtin_amdgcn_mfma_f32_32x32x16_bf16(PAF(0),VFR(4),o[1],0,0,0), C0,4); \
    KRD(GL,0); GAPB(o[0]=__builtin_amdgcn_mfma_f32_32x32x16_bf16(PAF(1),VFR(1),o[0],0,0,0), C0,8); \
    KRD(GL,1); GAPB(o[1]=__builtin_amdgcn_mfma_f32_32x32x16_bf16(PAF(1),VFR(5),o[1],0,0,0), C0,12); \
    KRD(GL,2); GAPB(o[0]=__builtin_amdgcn_mfma_f32_32x32x16_bf16(PAF(2),VFR(2),o[0],0,0,0), C1,0); \
    KRD(GL,3); GAPB(o[1]=__builtin_amdgcn_mfma_f32_32x32x16_bf16(PAF(2),VFR(6),o[1],0,0,0), C1,4); \
    GAPB(o[0]=__builtin_amdgcn_mfma_f32_32x32x16_bf16(PAF(3),VFR(3),o[0],0,0,0), C1,8); \
    GAPB(o[1]=__builtin_amdgcn_mfma_f32_32x32x16_bf16(PAF(3),VFR(7),o[1],0,0,0), C1,12); \
    }while(0)
  int t=1;
  for(;t+5<NTE;t+=2){
    STEP(pB0,pB1,pA0,pA1,t,true,true,true);     WAIT_BAR(2); RESC(); ROT();
    STEP(pA0,pA1,pB0,pB1,t+1,true,true,true);   WAIT_BAR(2); RESC(); ROT();
  }
  #define ENDW(tt) do{ if((tt)+3<NTE){WAIT_BAR(2);} else if((tt)+2<NTE){WAIT_BAR(1);} else {WAIT_BAR(0);} }while(0)
  for(;t+1<NTE;t+=2){
    STEP(pB0,pB1,pA0,pA1,t,(t+3<NTE),(t+1<NTE),(t+1<NTE));       ENDW(t);   RESC(); ROT();
    STEP(pA0,pA1,pB0,pB1,t+1,(t+4<NTE),(t+2<NTE),(t+2<NTE));     ENDW(t+1); RESC(); ROT();
  }
  STEP(pB0,pB1,pA0,pA1,NTE-1,false,false,false); RESC();
  { float sacc=pB0[0]+pB0[1]; _Pragma("unroll") for(int r=2;r<16;++r)sacc+=pB0[r]; _Pragma("unroll") for(int r=0;r<16;++r)sacc+=pB1[r]; l_reg+=sacc;
    pw0=(u32x4){PKW(pB0,0),PKW(pB0,2),PKW(pB0,4),PKW(pB0,6)};pw1=(u32x4){PKW(pB0,8),PKW(pB0,10),PKW(pB0,12),PKW(pB0,14)};pw2=(u32x4){PKW(pB1,0),PKW(pB1,2),PKW(pB1,4),PKW(pB1,6)};pw3=(u32x4){PKW(pB1,8),PKW(pB1,10),PKW(pB1,12),PKW(pB1,14)};
    SBAR(); pv(o,vb0+sl_cur,PAF(0),PAF(1),PAF(2),PAF(3)); }
  #undef PKW
  #undef PAF
  #undef VFR
  #undef PIN
  #undef MX3
  #undef GAPA
  #undef GAPB
  #undef EX
  #undef VRD
  #undef KRD
  #undef STEP
  #undef ENDW
  {auto rr=__builtin_amdgcn_permlane32_swap(__float_as_uint(l_reg),__float_as_uint(l_reg),false,false);l_reg=__uint_as_float(rr[0])+__uint_as_float(rr[1]);}
  if(hi==0)wsf[32+r32]=l_reg;asm volatile("s_waitcnt lgkmcnt(0)":::"memory");
  float rli[16];
  #pragma unroll
  for(int r=0;r<16;++r)rli[r]=__builtin_amdgcn_rcpf(wsf[32+crow(r,hi)]);
  bf16*Ow=O+(rowbase+q0+wid*QBLK)*DM+h*D;
  { bf16*stg=(bf16*)(shm+LDS_OST)+wid*2048;
    #pragma unroll
    for(int r=0;r<16;++r){const int orow=crow(r,hi);
      #pragma unroll
      for(int d0=0;d0<2;++d0)stg[orow*64+d0*32+r32]=__float2bfloat16(o[d0][r]*rli[r]);}
    asm volatile("s_waitcnt lgkmcnt(0)":::"memory");
    const bf16*Zw=Zg+(rowbase+q0+wid*QBLK)*DM+h*D;
    #pragma unroll
    for(int i=0;i<4;++i){const int row=i*8+(lane>>3),ch=lane&7; const u32x4 v=*(const u32x4*)(stg+row*64+ch*8); const u32x4 zz=*(const u32x4*)(Zw+(long)row*DM+ch*8); u32x4 w;
      w.x=gate2(v.x,zz.x);w.y=gate2(v.y,zz.y);w.z=gate2(v.z,zz.z);w.w=gate2(v.w,zz.w); if(do_store||w.x==0x12345678u)ATTN_STORE16(Ow+(long)row*DM+ch*8,w);} }
  asm volatile("s_waitcnt lgkmcnt(0)\n\ts_barrier":::"memory");
  #undef TILE
  #undef DMA_K
  #undef DMA_V
  #undef CMASK
  #undef CDEC
  #undef START
  #undef RESC
  #undef ROT
}
constexpr int ATTN_LDS_BYTES=LDS_BYTES;
struct AttnTensors { const bf16* Q; const bf16* K; const bf16* V; bf16* O; const bf16* Z; const float* C; const unsigned* NM; };
struct AttnUnit { int bh; int qb; };
struct StaticOrder {
  int vcu;
  __device__ __forceinline__ explicit StaticOrder(int grid,int block):vcu((block%8)*(grid/8)+block/8){}
  __device__ __forceinline__ bool next(int i,AttnUnit&u)const{ if(i>=4)return false; u.bh=(vcu+4*i)&31; u.qb=4*(vcu>>5)+i; return true; }
  __device__ __forceinline__ void a_ready(const AttnUnit&)const{}
  __device__ __forceinline__ void done(const AttnUnit&)const{}
};
template<class Sched,int THRL=8> __device__ __forceinline__ void attn_phase(char*lds,const AttnTensors&T,const Sched&S,const int wave_id,const bool do_store=true){
  AttnUnit u;
  if(S.next(0,u)){ attn_unit<THRL>(u.bh/NHEAD,u.bh%NHEAD,u.qb,T.Q,T.K,T.V,T.O,T.Z,T.C,T.NM,lds,wave_id,do_store); }
  if(S.next(1,u)){ attn_unit<THRL>(u.bh/NHEAD,u.bh%NHEAD,u.qb,T.Q,T.K,T.V,T.O,T.Z,T.C,T.NM,lds,wave_id,do_store); }
  if(S.next(2,u)){ attn_unit<THRL>(u.bh/NHEAD,u.bh%NHEAD,u.qb,T.Q,T.K,T.V,T.O,T.Z,T.C,T.NM,lds,wave_id,do_store); }
  if(S.next(3,u)){ attn_unit<THRL>(u.bh/NHEAD,u.bh%NHEAD,u.qb,T.Q,T.K,T.V,T.O,T.Z,T.C,T.NM,lds,wave_id,do_store); }

}
#undef SBAR
#undef WAIT_BAR
}

#define GAS __attribute__((address_space(1)))
#define LAS __attribute__((address_space(3)))
typedef unsigned short bf16;
typedef unsigned v4u __attribute__((ext_vector_type(4)));
typedef float f32x4 __attribute__((ext_vector_type(4)));
typedef short bf16x8 __attribute__((ext_vector_type(8)));
typedef GAS unsigned gu32;
typedef GAS unsigned long long gu64;
#define RLX_AGENT __ATOMIC_RELAXED, __HIP_MEMORY_SCOPE_AGENT
#define LDS_WAIT() asm volatile("s_waitcnt lgkmcnt(0)" ::: "memory")
#define VM_WAIT() asm volatile("s_waitcnt vmcnt(0)" ::: "memory")
__device__ __forceinline__ unsigned long long rt() { return __builtin_amdgcn_s_memrealtime(); }
__device__ __forceinline__ unsigned f2bf(float f) { unsigned u = __builtin_bit_cast(unsigned, f); return (u + 0x7fffu + ((u >> 16) & 1u)) >> 16; }
__device__ __forceinline__ unsigned pk2(float lo, float hi) { return f2bf(lo) | (f2bf(hi) << 16); }

#define XB_TMO      128
#define XB_XCNT(j)  (256  + 64 * (j))
#define XB_XSUB(j)  (1280 + 64 * (j))
#define XB_XGEN(j)  (2304 + 64 * (j))
#define XB_TOP      3328
#define XB_TOPGEN   3392
#define XCD_BAR_WORDS 3456
#define XB_SPIN_CAP (1u << 18)

__device__ __forceinline__ unsigned xb_ld(unsigned* p)              { return __hip_atomic_load(p, __ATOMIC_RELAXED, __HIP_MEMORY_SCOPE_AGENT); }
__device__ __forceinline__ unsigned xb_add(unsigned* p, unsigned v) { return __hip_atomic_fetch_add(p, v, __ATOMIC_RELAXED, __HIP_MEMORY_SCOPE_AGENT); }
__device__ __forceinline__ unsigned xb_xcc_id() { return (unsigned)__builtin_amdgcn_s_getreg((3 << 11) | 20) & 0xFu; }
#define XB_SPIN(cond, bar) do { unsigned _sp = 0; while (cond) { __builtin_amdgcn_s_sleep(1); \
    if ((++_sp & 255u) == 0u) { if (xb_ld(&(bar)[XB_TMO])) break; if (_sp > XB_SPIN_CAP) { atomicAdd(&(bar)[XB_TMO], 1u); break; } } } } while (0)

struct XcdBarrier {
    unsigned* bar; unsigned x; int wave;
    volatile LAS unsigned* st;
};

__device__ __forceinline__ XcdBarrier xcd_barrier_post(unsigned* bar, volatile LAS unsigned* st, int wave) {
    XcdBarrier b; b.bar = bar; b.x = xb_xcc_id(); b.st = st; b.wave = wave;
    if (wave == 0 && lane_id_() == 0) (void)xb_add(&bar[XB_XCNT(b.x)], 1u);
    return b;
}
__device__ __forceinline__ void xcd_barrier_complete(unsigned* bar, unsigned x, unsigned& nloc, unsigned& nx) {
    const unsigned G = gridDim.x * gridDim.y * gridDim.z;
    unsigned sum, cnt, mine, sp = 0u;
    for (;;) {
        sum = 0u; cnt = 0u; mine = 0u;
#pragma unroll
        for (unsigned j = 0; j < 16; ++j) { const unsigned c = xb_ld(&bar[XB_XCNT(j)]); sum += c; cnt += (c > 0u) ? 1u : 0u; mine = (j == x) ? c : mine; }
        if (sum == G) break;
        __builtin_amdgcn_s_sleep(1);
        if ((++sp & 255u) == 0u) { if (xb_ld(&bar[XB_TMO])) break; if (sp > XB_SPIN_CAP) { atomicAdd(&bar[XB_TMO], 1u); break; } }
    }
    nloc = mine > 0u ? mine : 1u; nx = cnt > 0u ? cnt : 1u;
}

__device__ __forceinline__ void xcd_barrier(const XcdBarrier& b) {
    asm volatile("s_waitcnt vmcnt(0)" ::: "memory");
    __syncthreads();
    if (b.wave == 0 && lane_id_() == 0) {
        unsigned* bar = b.bar;
        __builtin_amdgcn_s_waitcnt(0);
        unsigned nloc = b.st[0], nx = b.st[1];
        if (nloc == 0u) { xcd_barrier_complete(bar, b.x, nloc, nx); b.st[0] = nloc; b.st[1] = nx; }
        const unsigned old = xb_add(&bar[XB_XSUB(b.x)], 1u);
        const unsigned gen = old / nloc;
        if (old + 1u == (gen + 1u) * nloc) {
            __builtin_amdgcn_fence(__ATOMIC_RELEASE, "agent");
            asm volatile("s_waitcnt vmcnt(0)" ::: "memory");
            const unsigned og = xb_add(&bar[XB_TOP], 1u);
            const unsigned tg = og / nx;
            if (og + 1u == (tg + 1u) * nx) xb_add(&bar[XB_TOPGEN], 1u);
            else XB_SPIN(xb_ld(&bar[XB_TOPGEN]) == tg, bar);
            __builtin_amdgcn_fence(__ATOMIC_ACQUIRE, "agent");
            xb_add(&bar[XB_XGEN(b.x)], 1u);
            asm volatile("s_waitcnt vmcnt(0)" ::: "memory");
        } else {
            XB_SPIN(xb_ld(&bar[XB_XGEN(b.x)]) == gen, bar);
            __builtin_amdgcn_fence(__ATOMIC_ACQUIRE, "agent");
            asm volatile("s_waitcnt vmcnt(0)" ::: "memory");
        }
    }
    __syncthreads();
}

namespace dil {
using attn_body::bf16x8; using attn_body::s16x4; using attn_body::f32x16; using attn_body::u32x4; using attn_body::lds_cptr; using attn_body::vtr; using attn_body::cvtpk_s; using attn_body::crow;
constexpr int KS = 272, VS = 320, KBYTES = 64 * KS, VBYTES = 64 * VS, UNIT_LDS = KBYTES + VBYTES;
constexpr int WSF_OFF = 2 * UNIT_LDS, DIL_LDS_BYTES = WSF_OFF + 8 * 256;
constexpr int LDQ = 3072;
typedef __attribute__((address_space(3))) char* lds_ptr;
typedef __attribute__((address_space(3))) float* lds_fp;

__device__ __forceinline__ void dil_phase(char* lds_g, unsigned short* Qb, const unsigned short* __restrict__ Kb, const unsigned short* __restrict__ Vb, float* lse, int grid, int block, const int wave_id, const bool do_store = true) {
    int tid_ = wave_id * 64 + lane_id_(); asm volatile("" : "+v"(tid_)); const int tid = tid_, lane = tid & 63, r32 = lane & 31, hi = lane >> 5; const int wid = __builtin_amdgcn_readfirstlane(tid >> 6);
    const int half = wid >> 2, w4 = wid & 3, tu = tid & 255;
    const lds_ptr lds = (lds_ptr)lds_g;
    const lds_ptr Kl = lds + half * UNIT_LDS, Vl = Kl + KBYTES;
    const lds_fp wsf = (lds_fp)(lds + WSF_OFF) + wid * 64;
    for (int up = block; up < 768; up += grid) {
        const int u = 2 * up + half;
        const int g = u >> 9, rem = u & 511, h = rem & 7, pb = rem >> 3, dsh = 2 * g;
        const int nbm = (64 >> dsh) - 1, n = pb & nbm, r = pb >> (6 - dsh);
        const int colq = g * 1024 + h * 128;
        const int i_q = 32 * w4 + r32;
        const long tq = ((long)(128 * n + i_q) << dsh) + r;
        bf16x8 qr[8];
#pragma unroll
        for (int d0 = 0; d0 < 8; ++d0) qr[d0] = *(const bf16x8*)(Qb + tq * LDQ + colq + d0 * 16 + hi * 8);
        const float slope2 = __builtin_amdgcn_exp2f(-(float)(g * 8 + h + 1) * (8.0f / 24.0f)) * 1.4426950408889634f * (float)(1 << dsh);
        float mrun = -1e30f, l_reg = 0.f; f32x16 o[4];
#pragma unroll
        for (int d0 = 0; d0 < 4; ++d0) o[d0] = f32x16{};
        u32x4 kreg[4], vreg[4];
#define DIL_LOAD(kt) do { _Pragma("unroll") for (int i_ = 0; i_ < 4; ++i_) { const int p_ = tu + 256 * i_, row_ = p_ >> 4, ch_ = p_ & 15; \
            int lk_ = 128 * (n - 1) + 64 * (kt) + row_; lk_ = lk_ < 0 ? 0 : lk_; const long tk_ = ((long)lk_ << dsh) + r; \
            kreg[i_] = *(const u32x4*)(Kb + tk_ * LDQ + colq + ch_ * 8); vreg[i_] = *(const u32x4*)(Vb + tk_ * LDQ + colq + ch_ * 8); } } while (0)
        DIL_LOAD(0);
        const lds_cptr kb = (lds_cptr)Kl + r32 * KS + hi * 16;
        const lds_cptr vb = (lds_cptr)Vl + (4 * hi + ((lane & 15) >> 2)) * VS + ((lane >> 4) & 1) * 32 + (lane & 3) * 8;
#pragma unroll 1
        for (int kt = 0; kt < 4; ++kt) {
            __syncthreads();
#pragma unroll
            for (int i_ = 0; i_ < 4; ++i_) { const int p_ = tu + 256 * i_, row_ = p_ >> 4, ch_ = p_ & 15;
                *(__attribute__((address_space(3))) u32x4*)(Kl + row_ * KS + ch_ * 16) = kreg[i_]; *(__attribute__((address_space(3))) u32x4*)(Vl + row_ * VS + ch_ * 16) = vreg[i_]; }
            __syncthreads();
            if (kt < 3) DIL_LOAD(kt + 1);
            const bool active = (kt >= (w4 >> 1)) && (kt <= (w4 >> 1) + 2) && !(n == 0 && kt < 2);
            if (active) {
                f32x16 p0 = f32x16{}, p1 = f32x16{};
#pragma unroll
                for (int d0 = 0; d0 < 8; ++d0) {
                    const bf16x8 b0 = *(const __attribute__((address_space(3))) bf16x8*)(kb + d0 * 32);
                    const bf16x8 b1 = *(const __attribute__((address_space(3))) bf16x8*)(kb + 32 * KS + d0 * 32);
                    p0 = __builtin_amdgcn_mfma_f32_32x32x16_bf16(b0, qr[d0], p0, 0, 0, 0);
                    p1 = __builtin_amdgcn_mfma_f32_32x32x16_bf16(b1, qr[d0], p1, 0, 0, 0);
                }
                const int dbase = 128 + i_q - 64 * kt - 4 * hi; const bool nz = n > 0; const int jb = 64 * kt + 4 * hi;
                float rm = -INFINITY;
#pragma unroll
                for (int rr = 0; rr < 16; ++rr) { const int cr = (rr & 3) + 8 * (rr >> 2); const int d0_ = dbase - cr, d1_ = d0_ - 32;
                    const bool v0 = ((unsigned)d0_ <= 128u) && (nz || (jb + cr) >= 128), v1 = ((unsigned)d1_ <= 128u) && (nz || (jb + cr + 32) >= 128);
                    p0[rr] = v0 ? p0[rr] - slope2 * (float)d0_ : -INFINITY; p1[rr] = v1 ? p1[rr] - slope2 * (float)d1_ : -INFINITY;
                    rm = fmaxf(rm, fmaxf(p0[rr], p1[rr])); }
                { auto sw_ = __builtin_amdgcn_permlane32_swap(__float_as_uint(rm), __float_as_uint(rm), false, false); rm = fmaxf(__uint_as_float(sw_[0]), __uint_as_float(sw_[1])); }
                const float mnew = fmaxf(mrun, rm), alpha = __builtin_amdgcn_exp2f(mrun - mnew); mrun = mnew;
                float rs = 0.f;
#pragma unroll
                for (int rr = 0; rr < 16; ++rr) { p0[rr] = __builtin_amdgcn_exp2f(p0[rr] - mnew); p1[rr] = __builtin_amdgcn_exp2f(p1[rr] - mnew); rs += p0[rr] + p1[rr]; }
                l_reg = l_reg * alpha + rs;
                if (hi == 0) wsf[r32] = alpha;
                bf16x8 pa[4];
                { u32x4 w0, w1, w2, w3;
                  w0.x = cvtpk_s(p0[0], p0[1]); w0.y = cvtpk_s(p0[2], p0[3]); w0.z = cvtpk_s(p0[4], p0[5]); w0.w = cvtpk_s(p0[6], p0[7]);
                  w1.x = cvtpk_s(p0[8], p0[9]); w1.y = cvtpk_s(p0[10], p0[11]); w1.z = cvtpk_s(p0[12], p0[13]); w1.w = cvtpk_s(p0[14], p0[15]);
                  w2.x = cvtpk_s(p1[0], p1[1]); w2.y = cvtpk_s(p1[2], p1[3]); w2.z = cvtpk_s(p1[4], p1[5]); w2.w = cvtpk_s(p1[6], p1[7]);
                  w3.x = cvtpk_s(p1[8], p1[9]); w3.y = cvtpk_s(p1[10], p1[11]); w3.z = cvtpk_s(p1[12], p1[13]); w3.w = cvtpk_s(p1[14], p1[15]);
                  pa[0] = __builtin_bit_cast(bf16x8, w0); pa[1] = __builtin_bit_cast(bf16x8, w1); pa[2] = __builtin_bit_cast(bf16x8, w2); pa[3] = __builtin_bit_cast(bf16x8, w3); }
                { float al[16];
#pragma unroll
                  for (int rr = 0; rr < 16; ++rr) al[rr] = wsf[crow(rr, hi)];
#pragma unroll
                  for (int d0 = 0; d0 < 4; ++d0)
#pragma unroll
                      for (int rr = 0; rr < 16; ++rr) o[d0][rr] *= al[rr]; }
#pragma unroll
                for (int d0 = 0; d0 < 4; ++d0)
#pragma unroll
                    for (int ks = 0; ks < 4; ++ks) {
                        const s16x4 lo = vtr(vb + ks * 16 * VS + d0 * 64), hh = vtr(vb + ks * 16 * VS + 8 * VS + d0 * 64);
                        const bf16x8 vf = (bf16x8){lo[0], lo[1], lo[2], lo[3], hh[0], hh[1], hh[2], hh[3]};
                        o[d0] = __builtin_amdgcn_mfma_f32_32x32x16_bf16(pa[ks], vf, o[d0], 0, 0, 0);
                    }
            }
        }
#undef DIL_LOAD
        float ltot; { auto sw_ = __builtin_amdgcn_permlane32_swap(__float_as_uint(l_reg), __float_as_uint(l_reg), false, false); ltot = __uint_as_float(sw_[0]) + __uint_as_float(sw_[1]); }
        if (hi == 0) { wsf[32 + r32] = __builtin_amdgcn_rcpf(ltot); if (do_store) lse[((size_t)g * 8192 + tq) * 8 + h] = mrun + log2f(ltot); }
        __syncthreads();
        { const lds_ptr stg = Kl + w4 * 8192;
          float rl[16];
#pragma unroll
          for (int rr = 0; rr < 16; ++rr) rl[rr] = wsf[32 + crow(rr, hi)];
#pragma unroll
          for (int rr = 0; rr < 16; ++rr) { const int orow = crow(rr, hi);
#pragma unroll
              for (int d0 = 0; d0 < 4; ++d0) { const unsigned pk = cvtpk_s(o[d0][rr] * rl[rr], 0.f); *(__attribute__((address_space(3))) unsigned short*)(stg + orow * 256 + (d0 * 32 + r32) * 2) = (unsigned short)pk; } }
#pragma unroll
          for (int i_ = 0; i_ < 8; ++i_) { const int row = i_ * 4 + (lane >> 4), ch = lane & 15;
              const u32x4 v = *(const __attribute__((address_space(3))) u32x4*)(stg + row * 256 + ch * 16);
              const long tr = ((long)(128 * n + 32 * w4 + row) << dsh) + r;
              if (do_store || v.x == 0x12345678u) *(u32x4*)(Qb + tr * LDQ + colq + ch * 8) = v; } }
    }
    __syncthreads();
}
}

namespace cg = cooperative_groups;
constexpr int NWAVES = 8;
constexpr int BATCH = 2, SEQ = 8192, D = 1024, M = BATCH * SEQ, FOX_IN = 4112, DIL_IN = 10240, PLE = 256;
constexpr float RMS_EPS = 1e-6f, LOG2E = 1.4426950408889634f;
constexpr float C2D = 0.08838834764831845f * LOG2E;

constexpr size_t MiB = 1u << 20, KiB = 1024;
constexpr size_t WS_CTL = 0, CTL_ZERO_BYTES = 1 * MiB;
constexpr size_t WS_SS = 1 * MiB;
constexpr size_t WS_C = 2 * MiB;
constexpr size_t WS_LSE = 3 * MiB;
constexpr size_t WS_WFIN = 4 * MiB, WS_WFOUT = 12 * MiB, WS_WUP0 = 14 * MiB, WS_WG0 = 14 * MiB + 512 * KiB, WS_PB0 = 16 * MiB + 512 * KiB;
constexpr size_t WS_A1 = 24 * MiB + 512 * KiB;
constexpr size_t WS_PB1 = 56 * MiB + 512 * KiB, WS_WUP1 = 64 * MiB + 512 * KiB, WS_WG1 = 65 * MiB, WS_WDOUT = 67 * MiB, WS_WDIN = 69 * MiB;
constexpr size_t WS_Q = 89 * MiB, WS_K = 121 * MiB, WS_V = 153 * MiB, WS_Z = 185 * MiB;
constexpr size_t WS_Q1 = 89 * MiB, WS_K1 = 137 * MiB, WS_V1 = 185 * MiB, WS_Z1 = 233 * MiB;
constexpr size_t WS_A2 = 4 * MiB;
constexpr size_t WS_H3B = 89 * MiB, WS_U1 = 121 * MiB;
constexpr size_t WS_END = 256 * MiB;
static_assert(WS_WDIN + (size_t)DIL_IN * D * 2 <= WS_Q && WS_Z1 + (size_t)SEQ * D * 2 <= WS_END && WS_A2 + (size_t)M * D * 2 <= WS_A1 + (size_t)SEQ * D * 2, "d_ws map");
constexpr int CW_BAR = 4096, CW_NM = 8192;

constexpr int RING_OFF = 0, RING_BYTES = 131072;
constexpr int LDS_BYTES = 147456, LDSCTL_OFF = LDS_BYTES - 512, MISC_OFF = LDSCTL_OFF + 320;
static_assert(attn_body::LDS_BYTES <= RING_BYTES && dil::DIL_LDS_BYTES <= RING_BYTES, "LDS map");

struct Args { const float* in[12]; float* out; unsigned char* ws; };

__device__ __forceinline__ void p0_transpose_item(const float* W, int K, int ldw, int nblk, bf16* WT, LAS float* scr, int item, int lane) {
    const int kb = item / nblk, nb = item % nblk, k0 = 64 * kb, n0 = 32 * nb;
#pragma unroll 8
    for (int i = 0; i < 32; ++i) { const int kk = 2 * i + (lane >> 5); scr[kk * 33 + (lane & 31)] = W[(size_t)(k0 + kk) * ldw + n0 + (lane & 31)]; }
    LDS_WAIT(); asm volatile("" ::: "memory");
    const int c = lane & 7;
#pragma unroll
    for (int j = 0; j < 4; ++j) { const int n = (lane >> 3) + 8 * j; const LAS float* s = scr + (8 * c) * 33 + n;
        v4u o; o.x = pk2(s[0 * 33], s[1 * 33]); o.y = pk2(s[2 * 33], s[3 * 33]); o.z = pk2(s[4 * 33], s[5 * 33]); o.w = pk2(s[6 * 33], s[7 * 33]);
        *(GAS v4u*)(WT + (size_t)(n0 + n) * K + k0 + 8 * c) = o; }
    LDS_WAIT(); asm volatile("" ::: "memory");
}

__global__ void __launch_bounds__(NWAVES * 64, 2) trunk_fwd(Args args) {
    extern __shared__ __attribute__((aligned(16))) unsigned char lds[];
    LAS unsigned char* const ldsl = (LAS unsigned char*)lds;
    volatile LAS unsigned* const MISC = (volatile LAS unsigned*)(ldsl + MISC_OFF);
    const int wave = __builtin_amdgcn_readfirstlane((int)threadIdx.x >> 6);
#define FRESH_TID() int tid = wave * 64 + lane_id_(); asm volatile("" : "+v"(tid)); const int lane = tid & 63; (void)lane
    const int G = gridDim.x, bx = blockIdx.x, vcu = (G % 8 == 0) ? (bx % 8) * (G / 8) + bx / 8 : bx;
#define WSP (args.ws)
#define CTLP ((gu32*)(args.ws + WS_CTL))
#define IN_X (args.in[0])
#define IN_P (args.in[1])
#define IN_FNORM (args.in[2])
#define IN_FWIN (args.in[3])
#define IN_FBF (args.in[4])
#define IN_FWOUT (args.in[5])
#define IN_DNORM (args.in[6])
#define IN_DWIN (args.in[7])
#define IN_DWOUT (args.in[8])
#define IN_WUP (args.in[9])
#define IN_WGATE (args.in[10])
#define IN_FINORM (args.in[11])
#define HRES (args.out)
#define W_FIN ((bf16*)(args.ws + WS_WFIN))
#define W_FOUT ((bf16*)(args.ws + WS_WFOUT))
#define W_UP0 ((bf16*)(args.ws + WS_WUP0))
#define W_G0 ((bf16*)(args.ws + WS_WG0))
#define W_UP1 ((bf16*)(args.ws + WS_WUP1))
#define W_G1 ((bf16*)(args.ws + WS_WG1))
#define W_DOUT ((bf16*)(args.ws + WS_WDOUT))
#define W_DIN ((bf16*)(args.ws + WS_WDIN))
#define PB0 ((bf16*)(args.ws + WS_PB0))
#define PB1 ((bf16*)(args.ws + WS_PB1))
#define A1 ((bf16*)(args.ws + WS_A1))
#define A2 ((bf16*)(args.ws + WS_A2))
#define QB ((bf16*)(args.ws + WS_Q))
#define KB ((bf16*)(args.ws + WS_K))
#define VB ((bf16*)(args.ws + WS_V))
#define ZB ((bf16*)(args.ws + WS_Z))
#define Q1 ((bf16*)(args.ws + WS_Q1))
#define K1 ((bf16*)(args.ws + WS_K1))
#define V1 ((bf16*)(args.ws + WS_V1))
#define Z1 ((bf16*)(args.ws + WS_Z1))
#define SS ((float*)(args.ws + WS_SS))
#define CC ((float*)(args.ws + WS_C))
#define LSE ((float*)(args.ws + WS_LSE))
    for (int u = (int)threadIdx.x; u < (LDS_BYTES - LDSCTL_OFF) / 4; u += NWAVES * 64) ((LAS unsigned*)(ldsl + LDSCTL_OFF))[u] = 0u;
    __syncthreads();
    XcdBarrier bar = xcd_barrier_post((unsigned*)(CTLP + CW_BAR), MISC + 8, wave);
    const int gw = vcu * NWAVES + wave, NGW = G * NWAVES;

    {
        FRESH_TID();
        LAS float* scr = (LAS float*)(ldsl + wave * 16384);
        constexpr int I_FIN = 16 * 128, I_SQ = 16 * 32, I_DIN = 16 * 320, I_UP = 4 * 32;
        constexpr int NITEMS = I_FIN + 4 * I_SQ + I_DIN + 2 * I_UP;
        for (int it = gw; it < NITEMS; it += NGW) {
            int r = it;
            if (r < I_DIN) { p0_transpose_item(IN_DWIN, D, DIL_IN, 320, W_DIN, scr, r, lane); continue; } r -= I_DIN;
            if (r < I_FIN) { p0_transpose_item(IN_FWIN, D, FOX_IN, 128, W_FIN, scr, r, lane); continue; } r -= I_FIN;
            if (r < I_SQ) { p0_transpose_item(IN_FWOUT, D, D, 32, W_FOUT, scr, r, lane); continue; } r -= I_SQ;
            if (r < I_SQ) { p0_transpose_item(IN_DWOUT, D, D, 32, W_DOUT, scr, r, lane); continue; } r -= I_SQ;
            if (r < I_SQ) { p0_transpose_item(IN_WGATE, D, D, 32, W_G0, scr, r, lane); continue; } r -= I_SQ;
            if (r < I_SQ) { p0_transpose_item(IN_WGATE + (size_t)D * D, D, D, 32, W_G1, scr, r, lane); continue; } r -= I_SQ;
            if (r < I_UP) { p0_transpose_item(IN_WUP, PLE, D, 32, W_UP0, scr, r, lane); continue; } r -= I_UP;
            p0_transpose_item(IN_WUP + (size_t)PLE * D, PLE, D, 32, W_UP1, scr, r, lane);
        }
        { const size_t n8 = (size_t)2 * M * PLE / 8, half8 = (size_t)M * PLE / 8;
          for (size_t i = (size_t)gw * 64 + lane; i < n8; i += (size_t)NGW * 64) {
              const f32x4 a = *(const GAS f32x4*)(IN_P + i * 8), b = *(const GAS f32x4*)(IN_P + i * 8 + 4);
              v4u o; o.x = pk2(a[0], a[1]); o.y = pk2(a[2], a[3]); o.z = pk2(b[0], b[1]); o.w = pk2(b[2], b[3]);
              bf16* dst = i < half8 ? PB0 + i * 8 : PB1 + (i - half8) * 8; *(GAS v4u*)dst = o; } }
        __syncthreads();
        LAS float* wf = (LAS float*)ldsl;
        for (int idx = tid; idx < 16 * 1024; idx += NWAVES * 64) { const int k = idx >> 4, n = idx & 15; wf[n * 1024 + k] = IN_FWIN[(size_t)k * FOX_IN + 4096 + n]; }
        __syncthreads();
        f32x4 g4[4];
#pragma unroll
        for (int j = 0; j < 4; ++j) g4[j] = *(const GAS f32x4*)(IN_FNORM + 4 * lane + 256 * j);
        for (int m = 2 * gw; m < M; m += 2 * NGW) {
            f32x4 v[2][4]; float s2[2] = {0.f, 0.f};
#pragma unroll
            for (int rr = 0; rr < 2; ++rr)
#pragma unroll
                for (int j = 0; j < 4; ++j) { v[rr][j] = *(const GAS f32x4*)(IN_X + (size_t)(m + rr) * D + 4 * lane + 256 * j); s2[rr] += (v[rr][j].x * v[rr][j].x + v[rr][j].y * v[rr][j].y) + (v[rr][j].z * v[rr][j].z + v[rr][j].w * v[rr][j].w); }
#pragma unroll
            for (int rr = 0; rr < 2; ++rr) { const float rstd = 1.0f / sqrtf(wave_sum(s2[rr]) * (1.f / D) + RMS_EPS);
                GAS unsigned long long* o8 = (GAS unsigned long long*)(A1 + (size_t)(m + rr) * D) + lane;
#pragma unroll
                for (int j = 0; j < 4; ++j) { v[rr][j] = v[rr][j] * rstd * g4[j];
                    o8[64 * j] = (unsigned long long)pk2(v[rr][j].x, v[rr][j].y) | ((unsigned long long)pk2(v[rr][j].z, v[rr][j].w) << 32); } }
            float a0[16], a1[16];
#pragma unroll
            for (int n = 0; n < 16; ++n) { float t0 = 0.f, t1 = 0.f;
#pragma unroll
                for (int j = 0; j < 4; ++j) { const f32x4 w = *(const LAS f32x4*)(wf + n * 1024 + 256 * j + 4 * lane);
                    t0 += (v[0][j].x * w.x + v[0][j].y * w.y) + (v[0][j].z * w.z + v[0][j].w * w.w); t1 += (v[1][j].x * w.x + v[1][j].y * w.y) + (v[1][j].z * w.z + v[1][j].w * w.w); }
                a0[n] = t0; a1[n] = t1; if (n & 1) asm volatile("" ::: "memory"); }
#define TRED(a) do { \
            { const bool up_ = (lane & 32) != 0; _Pragma("unroll") for (int i = 0; i < 8; ++i) { const float snd = up_ ? a[i] : a[i + 8], kp = up_ ? a[i + 8] : a[i]; auto r_ = __builtin_amdgcn_permlane32_swap(__float_as_uint(snd), __float_as_uint(snd), false, false); a[i] = kp + __uint_as_float(up_ ? r_[0] : r_[1]); } } \
            { const bool up_ = (lane & 16) != 0; _Pragma("unroll") for (int i = 0; i < 4; ++i) { const float snd = up_ ? a[i] : a[i + 4], kp = up_ ? a[i + 4] : a[i]; a[i] = kp + shx<16>(snd); } } \
            { const bool up_ = (lane & 8) != 0; _Pragma("unroll") for (int i = 0; i < 2; ++i) { const float snd = up_ ? a[i] : a[i + 2], kp = up_ ? a[i + 2] : a[i]; a[i] = kp + shx<8>(snd); } } \
            { const bool up_ = (lane & 4) != 0; const float snd = up_ ? a[0] : a[1], kp = up_ ? a[1] : a[0]; a[0] = kp + shx<4>(snd); } \
            a[0] += shx<1>(a[0]); a[0] += shx<2>(a[0]); } while (0)
            TRED(a0); TRED(a1);
#undef TRED
            if ((lane & 3) == 0) { const int n = (lane >> 2) & 15; const float bf = IN_FBF[n];
#pragma unroll
                for (int rr = 0; rr < 2; ++rr) { const float fl = (rr ? a1[0] : a0[0]) + bf;
                    const float lf = fminf(fl, 0.f) - log1pf(expf(-fabsf(fl)));
                    const int mm = m + rr, b = mm / SEQ, s = mm % SEQ; CC[(size_t)(b * 16 + n) * SEQ + s] = lf; } }
        }
    }
    if (args.out == nullptr) cg::this_grid().sync();
    xcd_barrier(bar);

    if (bx < 32) {
        FRESH_TID();
        float* c = CC + (size_t)bx * SEQ + tid * 16; LAS float* wt = (LAS float*)(ldsl + LDSCTL_OFF);
        f32x4 v[4]; float run = 0.f;
#pragma unroll
        for (int j = 0; j < 4; ++j) { v[j] = *(const GAS f32x4*)(c + 4 * j); v[j].x += run; v[j].y += v[j].x; v[j].z += v[j].y; v[j].w += v[j].z; run = v[j].w; }
        LAS float* tt = (LAS float*)ldsl;
        tt[tid] = run;
        __syncthreads();
        float off = 0.f;
        for (int k = 0; k < lane; ++k) off += tt[wave * 64 + k];
        if (lane == 63) wt[wave] = off + run;
        __syncthreads();
        for (int w = 0; w < wave; ++w) off += wt[w];
#pragma unroll
        for (int j = 0; j < 4; ++j) { v[j] = (v[j] + off) * LOG2E; *(GAS f32x4*)(c + 4 * j) = v[j]; }
        __syncthreads();
    }
    {
        pg8::Gemm g{A1, W_FIN, M, 4096, D}; pg8::StaticOrder S; S.init(M, 4096, G, bx);
        pg8::EpiFoxIn E{QB, (size_t)(WS_K - WS_Q) / 2, attn_body::C2, (unsigned*)(CTLP + CW_NM)};
#ifndef NO_G1
        pg8::gemm_phase<pg8::EpiFoxIn, pg8::StaticOrder, true, true>(ldsl + RING_OFF, g, S, E, wave);
#endif
    }
    xcd_barrier(bar);

    {
        const attn_body::AttnTensors AT{(const attn_body::bf16*)QB, (const attn_body::bf16*)KB, (const attn_body::bf16*)VB, (attn_body::bf16*)QB, (const attn_body::bf16*)ZB, CC, (const unsigned*)(CTLP + CW_NM)};
        const attn_body::StaticOrder S(G, bx);
#ifndef NO_ATTN
        attn_body::attn_phase<attn_body::StaticOrder>((char*)lds + RING_OFF, AT, S, wave);
#endif

    }
    xcd_barrier(bar);

    {
        pg8::Gemm g{QB, W_FOUT, M, D, D}; pg8::StaticOrder S; S.init(M, D, G, bx);
        pg8::EpiResid E{IN_X, nullptr, KB};
#ifndef NO_G2
        pg8::gemm_phase<pg8::EpiResid, pg8::StaticOrder, true, true>(ldsl + RING_OFF, g, S, E, wave);
#endif
        int kple = PLE; asm volatile("" : "+s"(kple));
        pg8::Gemm g2{PB0, W_UP0, M, D, kple}; pg8::StaticOrder S2; S2.init(M, D, G, bx);
        pg8::EpiBf16<0> E2{VB, D, nullptr, 0, 0, 1.f};
#ifndef NO_G3
        pg8::gemm_phase<pg8::EpiBf16<0>, pg8::StaticOrder, true, true>(ldsl + RING_OFF, g2, S2, E2, wave);
#endif
    }
    xcd_barrier(bar);

    {
        pg8::Gemm g{KB, W_G0, M, D, D}; pg8::StaticOrder S; S.init(M, D, G, bx);
        pg8::EpiGate E{HRES, KB, VB, A1, IN_DNORM, SS};
#ifndef NO_G4
        pg8::gemm_phase<pg8::EpiGate, pg8::StaticOrder, true, true>(ldsl + RING_OFF, g, S, E, wave);
#endif
    }
    xcd_barrier(bar);

    for (int b = 0; b < BATCH; ++b) {
        {
            pg8::Gemm g{A1 + (size_t)b * SEQ * D, W_DIN, SEQ, DIL_IN, D}; pg8::StaticOrder S; S.init(SEQ, DIL_IN, G, bx);
            pg8::EpiIn1 E{Q1, K1, V1, Z1, SS + (size_t)b * SEQ * 16, C2D, RMS_EPS};
#ifndef NO_G5
            pg8::gemm_phase<pg8::EpiIn1, pg8::StaticOrder, true, true>(ldsl + RING_OFF, g, S, E, wave);
#endif
        }
        xcd_barrier(bar);
#ifndef NO_DIL
        dil::dil_phase((char*)lds + RING_OFF, Q1, K1, V1, LSE, G, bx, wave);
#endif

        xcd_barrier(bar);
        FRESH_TID();
        for (int t = gw; t < SEQ; t += NGW) {
#pragma unroll
            for (int part = 0; part < 2; ++part) { const int c = part * 512 + 8 * lane, h = c >> 7;
                const float l0 = LSE[((size_t)0 * SEQ + t) * 8 + h], l1 = LSE[((size_t)1 * SEQ + t) * 8 + h], l2 = LSE[((size_t)2 * SEQ + t) * 8 + h];
                const float mx = fmaxf(l0, fmaxf(l1, l2)); float w0 = __builtin_amdgcn_exp2f(l0 - mx), w1 = __builtin_amdgcn_exp2f(l1 - mx), w2 = __builtin_amdgcn_exp2f(l2 - mx);
                const float inv = 1.0f / (w0 + w1 + w2); w0 *= inv; w1 *= inv; w2 *= inv;
                const v4u o0 = *(const GAS v4u*)(Q1 + (size_t)t * 3072 + c), o1 = *(const GAS v4u*)(Q1 + (size_t)t * 3072 + 1024 + c), o2 = *(const GAS v4u*)(Q1 + (size_t)t * 3072 + 2048 + c);
                const v4u zz = *(const GAS v4u*)(Z1 + (size_t)t * D + c); v4u r;
#define MRG1(f) { const float e0 = w0 * pg8::bf_lo(o0.f) + w1 * pg8::bf_lo(o1.f) + w2 * pg8::bf_lo(o2.f), e1 = w0 * pg8::bf_hi(o0.f) + w1 * pg8::bf_hi(o1.f) + w2 * pg8::bf_hi(o2.f); \
                 const float z0 = pg8::bf_lo(zz.f), z1 = pg8::bf_hi(zz.f); r.f = pk2(e0 * z0 * pg8::sigmoid_f(z0), e1 * z1 * pg8::sigmoid_f(z1)); }
                MRG1(x) MRG1(y) MRG1(z) MRG1(w)
#undef MRG1
                *(GAS v4u*)(A2 + ((size_t)b * SEQ + t) * D + c) = r; }
        }
        xcd_barrier(bar);
    }

    {
        bf16* const H3B = (bf16*)(WSP + WS_H3B); bf16* const U1 = (bf16*)(WSP + WS_U1);
        pg8::Gemm g{A2, W_DOUT, M, D, D}; pg8::StaticOrder S; S.init(M, D, G, bx);
        pg8::EpiResid E{HRES, nullptr, H3B};
#ifndef NO_G6
        pg8::gemm_phase<pg8::EpiResid, pg8::StaticOrder, true, true>(ldsl + RING_OFF, g, S, E, wave);
#endif
        int kple = PLE; asm volatile("" : "+s"(kple));
        pg8::Gemm g2{PB1, W_UP1, M, D, kple}; pg8::StaticOrder S2; S2.init(M, D, G, bx);
        pg8::EpiBf16<0> E2{U1, D, nullptr, 0, 0, 1.f};
#ifndef NO_G7
        pg8::gemm_phase<pg8::EpiBf16<0>, pg8::StaticOrder, true, true>(ldsl + RING_OFF, g2, S2, E2, wave);
#endif
        xcd_barrier(bar);
        pg8::Gemm g3{H3B, W_G1, M, D, D}; pg8::StaticOrder S3; S3.init(M, D, G, bx);
        pg8::EpiGate E3{HRES, H3B, U1, nullptr, nullptr, nullptr};
#ifndef NO_G8
        pg8::gemm_phase<pg8::EpiGate, pg8::StaticOrder, true, true>(ldsl + RING_OFF, g3, S3, E3, wave);
#endif
    }
    xcd_barrier(bar);

    {
        FRESH_TID();
        f32x4 g4[4];
#pragma unroll
        for (int j = 0; j < 4; ++j) g4[j] = *(const GAS f32x4*)(IN_FINORM + 4 * lane + 256 * j);
        for (int m = gw; m < M; m += NGW) {
            f32x4 v[4]; float s2 = 0.f; GAS f32x4* row = (GAS f32x4*)(HRES + (size_t)m * D) + lane;
#pragma unroll
            for (int j = 0; j < 4; ++j) { v[j] = row[64 * j]; s2 += (v[j].x * v[j].x + v[j].y * v[j].y) + (v[j].z * v[j].z + v[j].w * v[j].w); }
            const float rstd = 1.0f / sqrtf(wave_sum(s2) * (1.f / D) + RMS_EPS);
#pragma unroll
            for (int j = 0; j < 4; ++j) row[64 * j] = v[j] * rstd * g4[j];
        }
    }
}

extern "C" void kernel_launch(void* const* d_in, const int* in_sizes, int n_in, void* d_out, int out_size, void* d_ws, size_t ws_size, hipStream_t stream) {
    static int grid = 0;
    if (grid == 0) {
        if (n_in != 12 || in_sizes[0] != M * D || out_size != M * D || ws_size < WS_END) { fprintf(stderr, "kernel_launch: unexpected shapes (n_in %d, in0 %d, out %d, ws %zu); nothing launched\n", n_in, n_in > 0 ? in_sizes[0] : -1, out_size, ws_size); grid = -1; return; }
        int dev = 0, cus = 0, per_cu = 0;
        if (hipGetDevice(&dev) != hipSuccess || hipDeviceGetAttribute(&cus, hipDeviceAttributeMultiprocessorCount, dev) != hipSuccess) { grid = -1; return; }
        if (hipFuncSetAttribute((const void*)trunk_fwd, hipFuncAttributeMaxDynamicSharedMemorySize, LDS_BYTES) != hipSuccess) { fprintf(stderr, "kernel_launch: hipFuncSetAttribute failed\n"); grid = -1; return; }
        if (hipOccupancyMaxActiveBlocksPerMultiprocessor(&per_cu, (const void*)trunk_fwd, NWAVES * 64, LDS_BYTES) != hipSuccess || per_cu < 1) { fprintf(stderr, "kernel_launch: occupancy query says %d\n", per_cu); per_cu = 1; }
        (void)hipGetLastError();
        grid = cus;
        if (grid != 256) fprintf(stderr, "kernel_launch: %d CUs; the one-unit-per-CU GEMM phases assume 256\n", grid);
    }
    if (grid < 0) return;
    (void)hipMemsetAsync((char*)d_ws + WS_CTL, 0, CTL_ZERO_BYTES, stream);
    Args a{};
    for (int i = 0; i < 12; ++i) a.in[i] = (const float*)d_in[i];
    a.out = (float*)d_out; a.ws = (unsigned char*)d_ws;
    void* kargs[] = {&a};
    const hipError_t le = hipLaunchCooperativeKernel((const void*)trunk_fwd, dim3(grid), dim3(NWAVES * 64), kargs, LDS_BYTES, stream);
    if (le != hipSuccess) fprintf(stderr, "kernel_launch: cooperative launch failed: %s (grid %d)\n", hipGetErrorName(le), grid);
}
```
